# Optimizing an MI355X kernel written in HIP

```python
import jax, jax.numpy as jnp
from jax import lax
import numpy as np

D_MODEL = 2048
BATCH = 2
SEQ = 16384
DEPTH = 2

CONV_WIDTH = D_MODEL // 2
CONV_GROUPS = 8
CONV_K = 3
SGU_WIDTH = D_MODEL // 2
SGU_GROUPS = 8
SGU_GROUP_DIM = SGU_WIDTH // SGU_GROUPS
SGU_CHUNK = 128
MIX_IN_WIDTH = 3 * CONV_WIDTH + 2 * SGU_WIDTH
N_HEADS = 16
HEAD_DIM = D_MODEL // N_HEADS
MOBA_BLOCK = 256
MOBA_TOPK = 3
Q_CHUNK = 32
D_FF = 4 * D_MODEL
N_EVEN = (DEPTH + 1) // 2
N_ODD = DEPTH // 2
EPS = 1e-6

kernel_name = "hybrid_conv_sgu_moba_block"


def rms_norm(x, g):
    xf = x.astype(jnp.float32)
    y = xf * lax.rsqrt(jnp.mean(xf * xf, axis=-1, keepdims=True) + EPS)
    return (y * g.astype(jnp.float32)).astype(x.dtype)


def alibi_slopes():
    return 2.0 ** (-8.0 * jnp.arange(1, N_HEADS + 1, dtype=jnp.float32) / N_HEADS)


def conv_sgu_mixer(h, w_in, conv_w, sgu_gain, w_s, b_s, w_out):
    B_, S, _ = h.shape
    z = h @ w_in
    gate_b, gate_c, xa, u, v = jnp.split(
        z, [CONV_WIDTH, 2 * CONV_WIDTH, 3 * CONV_WIDTH, 3 * CONV_WIDTH + SGU_WIDTH], axis=-1)
    y = gate_c * xa
    yp = jnp.pad(y, ((0, 0), (CONV_K - 1, 0), (0, 0)))
    conv = yp[:, 0:S, :] * conv_w[:, 0]
    for tap in range(1, CONV_K):
        conv = conv + yp[:, tap:tap + S, :] * conv_w[:, tap]
    a_out = gate_b * conv
    u = jax.nn.gelu(u)
    v = jax.nn.gelu(v).reshape(B_, S // SGU_CHUNK, SGU_CHUNK, SGU_GROUPS, SGU_GROUP_DIM)
    v = rms_norm(v, sgu_gain.reshape(SGU_GROUPS, SGU_GROUP_DIM))
    causal = jnp.tril(jnp.ones((SGU_CHUNK, SGU_CHUNK), dtype=bool))
    w_causal = jnp.where(causal[None], w_s, jnp.zeros_like(w_s))
    mixed = jnp.einsum('gij,bcjgd->bcigd', w_causal, v) + b_s.T[None, None, :, :, None]
    b_out = u * mixed.reshape(B_, S, SGU_WIDTH)
    return jnp.concatenate([a_out, b_out], axis=-1) @ w_out


def moba_attention(q, k, v):
    B_, H, S, hd = q.shape
    s_pad = -(-S // MOBA_BLOCK) * MOBA_BLOCK
    pad = ((0, 0), (0, 0), (0, s_pad - S), (0, 0))
    q, k, v = jnp.pad(q, pad), jnp.pad(k, pad), jnp.pad(v, pad)
    nb = s_pad // MOBA_BLOCK
    topk = min(MOBA_TOPK, nb)
    k_blocks = k.reshape(B_, H, nb, MOBA_BLOCK, hd)
    v_blocks = v.reshape(B_, H, nb, MOBA_BLOCK, hd)
    k_mean = jnp.mean(k_blocks.astype(jnp.float32), axis=3)
    scale = HEAD_DIM ** -0.5
    slopes = alibi_slopes()
    b_ix = jnp.arange(B_)[:, None, None, None]
    h_ix = jnp.arange(H)[None, :, None, None]
    blk_off = jnp.arange(MOBA_BLOCK)

    def chunk(c):
        q0 = c * Q_CHUNK
        qc = lax.dynamic_slice_in_dim(q, q0, Q_CHUNK, axis=2)
        t = q0 + jnp.arange(Q_CHUNK)
        own = q0 // MOBA_BLOCK
        gate = jnp.einsum('bhqd,bhnd->bhqn', qc.astype(jnp.float32), k_mean)
        gate = jnp.where(jnp.arange(nb) < own, gate, -jnp.inf)
        _, idx = lax.top_k(gate, topk)
        valid = jnp.arange(topk) < own
        kg = k_blocks[b_ix, h_ix, idx]
        vg = v_blocks[b_ix, h_ix, idx]
        kpos = idx[..., None] * MOBA_BLOCK + blk_off
        dist_sel = (t[None, None, :, None, None] - kpos).astype(jnp.float32)
        s_sel = (jnp.einsum('bhqd,bhqjkd->bhqjk', qc, kg).astype(jnp.float32) * scale
                 - slopes[None, :, None, None, None] * dist_sel)
        s_sel = jnp.where(valid[:, None], s_sel, -jnp.inf).reshape(B_, H, Q_CHUNK, topk * MOBA_BLOCK)
        k_own = lax.dynamic_index_in_dim(k_blocks, own, axis=2, keepdims=False)
        v_own = lax.dynamic_index_in_dim(v_blocks, own, axis=2, keepdims=False)
        own_pos = own * MOBA_BLOCK + blk_off
        dist_own = (t[:, None] - own_pos[None, :]).astype(jnp.float32)
        s_own = (jnp.einsum('bhqd,bhkd->bhqk', qc, k_own).astype(jnp.float32) * scale
                 - slopes[None, :, None, None] * dist_own)
        s_own = jnp.where(own_pos[None, :] <= t[:, None], s_own, -jnp.inf)
        p = jax.nn.softmax(jnp.concatenate([s_sel, s_own], axis=-1), axis=-1)
        p_sel = p[..., :topk * MOBA_BLOCK].reshape(B_, H, Q_CHUNK, topk, MOBA_BLOCK).astype(v.dtype)
        p_own = p[..., topk * MOBA_BLOCK:].astype(v.dtype)
        return (jnp.einsum('bhqjk,bhqjkd->bhqd', p_sel, vg)
                + jnp.einsum('bhqk,bhkd->bhqd', p_own, v_own))

    outs = lax.map(chunk, jnp.arange(s_pad // Q_CHUNK))
    out = outs.transpose(1, 0, 3, 2, 4).reshape(B_, s_pad, H * hd)
    return out[:, :S]


def moba_mixer(h, w_qkv, q_gain, k_gain, w_o):
    B_, S, _ = h.shape
    qkv = (h @ w_qkv).reshape(B_, S, 3, N_HEADS, HEAD_DIM)
    q = rms_norm(qkv[:, :, 0], q_gain).transpose(0, 2, 1, 3)
    k = rms_norm(qkv[:, :, 1], k_gain).transpose(0, 2, 1, 3)
    v = qkv[:, :, 2].transpose(0, 2, 1, 3)
    return moba_attention(q, k, v) @ w_o


def channel_mlp(h, w_up, w_down):
    a = jax.nn.relu(h @ w_up)
    return (a * a) @ w_down


def setup_inputs(seed: int = 0) -> dict:
    key = jax.random.key(seed)
    ks = jax.random.split(key, 16)
    f32 = jnp.float32
    nrm = lambda k, shape, fan_in: jax.random.normal(k, shape, f32) * (fan_in ** -0.5)
    gain = lambda k, shape: 1.0 + 0.02 * jax.random.normal(k, shape, f32)
    return {
        "x": jax.random.normal(ks[0], (BATCH, SEQ, D_MODEL), f32),
        "mix_norm": gain(ks[1], (DEPTH, D_MODEL)),
        "ffn_norm": gain(ks[2], (DEPTH, D_MODEL)),
        "w_in": nrm(ks[3], (N_EVEN, D_MODEL, MIX_IN_WIDTH), D_MODEL),
        "conv_w": nrm(ks[4], (N_EVEN, CONV_WIDTH, CONV_K), CONV_K),
        "sgu_gain": gain(ks[5], (N_EVEN, SGU_WIDTH)),
        "w_s": nrm(ks[6], (N_EVEN, SGU_GROUPS, SGU_CHUNK, SGU_CHUNK), SGU_CHUNK),
        "b_s": 1.0 + 0.02 * jax.random.normal(ks[7], (N_EVEN, SGU_GROUPS, SGU_CHUNK), f32),
        "w_mix_out": nrm(ks[8], (N_EVEN, D_MODEL, D_MODEL), D_MODEL),
        "w_qkv": nrm(ks[9], (N_ODD, D_MODEL, 3 * D_MODEL), D_MODEL),
        "q_gain": gain(ks[10], (N_ODD, HEAD_DIM)),
        "k_gain": gain(ks[11], (N_ODD, HEAD_DIM)),
        "w_attn_out": nrm(ks[12], (N_ODD, D_MODEL, D_MODEL), D_MODEL),
        "w_up": nrm(ks[13], (DEPTH, D_MODEL, D_FF), D_MODEL),
        "w_down": nrm(ks[14], (DEPTH, D_FF, D_MODEL), D_FF),
    }


def reference(x, mix_norm, ffn_norm, w_in, conv_w, sgu_gain, w_s, b_s, w_mix_out,
              w_qkv, q_gain, k_gain, w_attn_out, w_up, w_down):
    for layer in range(DEPTH):
        i = layer // 2
        h = rms_norm(x, mix_norm[layer])
        if layer % 2 == 0:
            x = x + conv_sgu_mixer(h, w_in[i], conv_w[i], sgu_gain[i], w_s[i], b_s[i], w_mix_out[i])
        else:
            x = x + moba_mixer(h, w_qkv[i], q_gain[i], k_gain[i], w_attn_out[i])
        h = rms_norm(x, ffn_norm[layer])
        x = x + channel_mlp(h, w_up[layer], w_down[layer])
    return x
```

```cpp
#define MK_PER_PHASE 1
#include <hip/hip_runtime.h>
#include <cstdio>
#include <cstdint>

namespace pg8 {
#define PG8_LAS __attribute__((address_space(3)))
typedef unsigned short bf16_t;
typedef short bf16x8 __attribute__((ext_vector_type(8)));
typedef float f32x4 __attribute__((ext_vector_type(4)));
typedef unsigned u32x4 __attribute__((ext_vector_type(4)));
constexpr int BM = 256, BK = 64, HALF = 128, HTB = HALF * BK * 2  , STAGE_BYTES = 8 * HTB, NXCD = 8, WGM = 8;

__host__ __device__ __forceinline__ int lds_byte(int r, int c) { const int st = (r >> 4) * 2 + (c >> 5), rr = r & 15, cc = c & 31, ob = rr * 64 + cc * 2; return st * 1024 + (ob ^ (((ob >> 9) & 1) << 5)); }
__host__ __device__ __forceinline__ void stage_rc(int b, int& R, int& C) { const int st = b / 1024, sb = b % 1024, swz = sb ^ (((sb >> 9) & 1) << 5); R = (st >> 1) * 16 + swz / 64; C = (st & 1) * 32 + (swz % 64) / 2; }
__host__ __device__ __forceinline__ int perm32(int rho) { const int n = rho >> 4, i = rho & 15; return 8 * (i >> 2) + 4 * n + (i & 3); }

struct Unit { int pm, pn; };
struct Gemm { const bf16_t* A; const bf16_t* Bt; int M, N, K; };

struct StaticOrder {
    int nM, nN, nwg, G, c;
    __host__ __device__ void init(int M, int N, int G_, int c_) { nM = M / BM; nN = N / BM; nwg = nM * nN; G = G_; c = c_; }
    __host__ __device__ bool next(int i, Unit& u) const {
        const long L = (long)i * G + c; if (L >= nwg) return false;
        int wgid = (int)L; { const int q = nwg / NXCD, r = nwg % NXCD, xcd = wgid % NXCD, off = wgid / NXCD; wgid = (xcd < r ? xcd * (q + 1) : r * (q + 1) + (xcd - r) * q) + off; }
        const int nig = WGM * nN, gid = wgid / nig, fm = gid * WGM, gsz = (nM - fm) < WGM ? (nM - fm) : WGM;
        u.pm = fm + ((wgid % nig) % gsz); u.pn = (wgid % nig) / gsz; return true;
    }
    __device__ __forceinline__ void a_ready(const Unit&) const {}
    __device__ __forceinline__ void done(const Unit&) const {}
};

__device__ __forceinline__ unsigned cvt_pk_bf16(float lo, float hi) { unsigned r; asm volatile("v_cvt_pk_bf16_f32 %0, %1, %2" : "=v"(r) : "v"(lo), "v"(hi)); return r; }
typedef float f32x2 __attribute__((ext_vector_type(2)));
__device__ __forceinline__ f32x2 gelu_pk(f32x2 v) {
    const f32x2 av = __builtin_elementwise_abs(v), d = av * 0.2316418882f + 1.0f;
    f32x2 t; t.x = __builtin_amdgcn_rcpf(d.x); t.y = __builtin_amdgcn_rcpf(d.y);
    f32x2 q = t * 0.5307027145f + (-0.7265760135f); q = q * t + 0.7107068705f; q = q * t + (-0.142248368f); q = q * t + 0.127414796f; q = q * t;
    const f32x2 s = (v * v) * (-0.72134752044f);
    f32x2 e; e.x = __builtin_amdgcn_exp2f(s.x); e.y = __builtin_amdgcn_exp2f(s.y);
    const f32x2 m = v * (q * e), r = v - m;
    f32x2 o; o.x = v.x < 0.f ? m.x : r.x; o.y = v.y < 0.f ? m.y : r.y; return o;
}

template <class Epi, class Sched, bool ALIGN_EPI = false, bool SP2 = false>
__device__ __forceinline__ void gemm_phase(PG8_LAS unsigned char* lds, const Gemm g, const Sched& S, const Epi& E) {
    const int tid = threadIdx.x, wid = __builtin_amdgcn_readfirstlane(tid >> 6), lane = tid & 63, wr = wid >> 2, wc = wid & 3, fr = lane & 15, fq = lane >> 4;
    const int K = g.K, nt = K / BK;
    unsigned voffA[2], voffB[2];
#pragma unroll
    for (int i = 0; i < 2; ++i) { int R, C; stage_rc(tid * 16 + i * 8192, R, C); const int Rb = Epi::PERM ? ((R & ~31) + perm32(R & 31)) : R;
        voffA[i] = (unsigned)(R * K + C) * 2u; voffB[i] = (unsigned)(Rb * K + C) * 2u; }
    const size_t kstep = (size_t)(BK * 2);
    const size_t hstep = (size_t)HALF * K * 2;
    const size_t tstep = 2 * hstep;
    const unsigned ldsw = (unsigned)wid * 1024u;
    const int aoff = lds_byte(wr * 64 + fr, fq * 8), boff = lds_byte(wc * 32 + fr, fq * 8);
#define PG8_SA(b, h) (((b) * 2 + (h)) * HTB)
#define PG8_SB(b, h) ((4 + (b) * 2 + (h)) * HTB)
#define PG8_STAGE(bufoff, gbase, voff) do { _Pragma("unroll") for (int _i = 0; _i < 2; ++_i) \
        __builtin_amdgcn_global_load_lds((const unsigned*)((const char*)(gbase) + (voff)[_i]), (PG8_LAS unsigned*)(lds + (bufoff) + ldsw + _i * 8192), 16, 0, 0); } while (0)
#define PG8_LDA(dst, b, h) do { _Pragma("unroll") for (int m = 0; m < 4; ++m) _Pragma("unroll") for (int k = 0; k < 2; ++k) dst[m][k] = *(const PG8_LAS bf16x8*)(lds + PG8_SA(b, h) + aoff + m * 2048 + k * 1024); } while (0)
#define PG8_LDB(dst, b, h) do { _Pragma("unroll") for (int n = 0; n < 2; ++n) _Pragma("unroll") for (int k = 0; k < 2; ++k) dst[n][k] = *(const PG8_LAS bf16x8*)(lds + PG8_SB(b, h) + boff + n * 2048 + k * 1024); } while (0)
#define PG8_MMA(ai, bj, At, Bt) do { __builtin_amdgcn_s_setprio(1); _Pragma("unroll") for (int m = 0; m < 4; ++m) _Pragma("unroll") for (int n = 0; n < 2; ++n) _Pragma("unroll") for (int k = 0; k < 2; ++k) \
        acc[ai][bj][m][n] = __builtin_amdgcn_mfma_f32_16x16x32_bf16(Bt[n][k], At[m][k], acc[ai][bj][m][n], 0, 0, 0); __builtin_amdgcn_s_setprio(0); } while (0)
#define PG8_WAIT_V(n) asm volatile("s_waitcnt vmcnt(" #n ")" ::: "memory")
#define PG8_WAIT_L(n) asm volatile("s_waitcnt lgkmcnt(" #n ")" ::: "memory")
#define PG8_BAR __builtin_amdgcn_s_barrier()
#define PG8_SCHED __builtin_amdgcn_sched_barrier(0)
    Unit cur, nxt; int ui = 0;
    if (!S.next(0, cur)) return;
    f32x4 acc[2][2][4][2];
#pragma unroll
    for (int a = 0; a < 2; ++a)
#pragma unroll
        for (int b = 0; b < 2; ++b)
#pragma unroll
            for (int m = 0; m < 4; ++m)
#pragma unroll
                for (int n = 0; n < 2; ++n) acc[a][b][m][n] = (f32x4){0.f, 0.f, 0.f, 0.f};
    bf16x8 At[4][2], B0[2][2], B1[2][2];
    const char* cA = (const char*)g.A + (size_t)cur.pm * tstep; const char* cB = (const char*)g.Bt + (size_t)cur.pn * tstep;
    S.a_ready(cur);
    if constexpr (SP2) {
        PG8_STAGE(PG8_SB(0, 0), cB, voffB); PG8_STAGE(PG8_SB(0, 1), cB + hstep, voffB); PG8_STAGE(PG8_SA(0, 0), cA, voffA); PG8_STAGE(PG8_SA(0, 1), cA + hstep, voffA);
        if (wr == 1) PG8_BAR;
        PG8_WAIT_V(2); PG8_BAR;
        PG8_STAGE(PG8_SB(1, 0), cB + kstep, voffB); PG8_STAGE(PG8_SA(1, 0), cA + kstep, voffA); PG8_STAGE(PG8_SB(1, 1), cB + hstep + kstep, voffB);
        PG8_WAIT_V(6); PG8_BAR;
    } else {
        PG8_STAGE(PG8_SB(0, 0), cB, voffB); PG8_STAGE(PG8_SA(0, 0), cA, voffA); PG8_STAGE(PG8_SB(0, 1), cB + hstep, voffB); PG8_STAGE(PG8_SA(0, 1), cA + hstep, voffA);
        if (wr == 1) PG8_BAR;
        PG8_WAIT_V(4); PG8_BAR;
        PG8_STAGE(PG8_SB(1, 0), cB + kstep, voffB); PG8_STAGE(PG8_SA(1, 0), cA + kstep, voffA); PG8_STAGE(PG8_SB(1, 1), cB + hstep + kstep, voffB);
        PG8_WAIT_V(6); PG8_BAR;
    }
    for (;;) {
        const bool has_next = S.next(ui + 1, nxt);
        const char* nA = has_next ? (const char*)g.A + (size_t)nxt.pm * tstep : cA; const char* nB = has_next ? (const char*)g.Bt + (size_t)nxt.pn * tstep : cB;
        for (int t = 0; t < nt; t += 2) {
            const bool last = (t == nt - 2);
            const char* a1 = cA + (size_t)(t + 1) * kstep;
            const char* a2 = last ? nA : cA + (size_t)(t + 2) * kstep; const char* b2 = last ? nB : cB + (size_t)(t + 2) * kstep;
            const char* a3 = a2 + kstep; const char* b3 = b2 + kstep;
            if (last && has_next) S.a_ready(nxt);
            if constexpr (SP2) {
            PG8_LDB(B0, 0, 0); PG8_LDB(B1, 0, 1); PG8_SCHED; PG8_LDA(At, 0, 0); PG8_STAGE(PG8_SA(1, 1), a1 + hstep, voffA);
            PG8_WAIT_V(8); PG8_WAIT_L(0); PG8_BAR; PG8_MMA(0, 0, At, B0); PG8_MMA(0, 1, At, B1); PG8_BAR; PG8_SCHED;
            PG8_LDA(At, 0, 1); PG8_STAGE(PG8_SB(0, 0), b2, voffB); PG8_STAGE(PG8_SB(0, 1), b2 + hstep, voffB); PG8_STAGE(PG8_SA(0, 0), a2, voffA);
            PG8_WAIT_V(8); PG8_WAIT_L(0); PG8_BAR; PG8_MMA(1, 0, At, B0); PG8_MMA(1, 1, At, B1); PG8_BAR; PG8_SCHED;
            PG8_LDB(B0, 1, 0); PG8_LDB(B1, 1, 1); PG8_SCHED; PG8_LDA(At, 1, 0); PG8_STAGE(PG8_SA(0, 1), a2 + hstep, voffA);
            PG8_WAIT_V(8); PG8_WAIT_L(0); PG8_BAR; PG8_MMA(0, 0, At, B0); PG8_MMA(0, 1, At, B1); PG8_BAR; PG8_SCHED;
            PG8_LDA(At, 1, 1); PG8_STAGE(PG8_SB(1, 0), b3, voffB); PG8_STAGE(PG8_SB(1, 1), b3 + hstep, voffB); PG8_STAGE(PG8_SA(1, 0), a3, voffA);
            PG8_WAIT_V(8); PG8_WAIT_L(0); PG8_BAR; PG8_MMA(1, 0, At, B0); PG8_MMA(1, 1, At, B1); PG8_BAR; PG8_SCHED;
            } else {
            PG8_LDB(B0, 0, 0); PG8_SCHED; PG8_LDA(At, 0, 0); PG8_STAGE(PG8_SA(1, 1), a1 + hstep, voffA);
            PG8_WAIT_L(8); PG8_BAR; PG8_WAIT_L(0); PG8_MMA(0, 0, At, B0); PG8_BAR; PG8_SCHED;
            PG8_LDB(B1, 0, 1); PG8_STAGE(PG8_SB(0, 0), b2, voffB);
            PG8_BAR; PG8_WAIT_L(0); PG8_MMA(0, 1, At, B1); PG8_BAR;
            PG8_LDA(At, 0, 1); PG8_STAGE(PG8_SA(0, 0), a2, voffA);
            PG8_BAR; PG8_WAIT_L(0); PG8_MMA(1, 0, At, B0); PG8_BAR; PG8_SCHED;
            PG8_STAGE(PG8_SB(0, 1), b2 + hstep, voffB);
            PG8_WAIT_V(6); PG8_BAR; PG8_MMA(1, 1, At, B1); PG8_BAR;
            PG8_LDB(B0, 1, 0); PG8_SCHED; PG8_LDA(At, 1, 0); PG8_STAGE(PG8_SA(0, 1), a2 + hstep, voffA);
            PG8_WAIT_L(8); PG8_BAR; PG8_WAIT_L(0); PG8_MMA(0, 0, At, B0); PG8_BAR; PG8_SCHED;
            PG8_LDB(B1, 1, 1); PG8_STAGE(PG8_SB(1, 0), b3, voffB);
            PG8_BAR; PG8_WAIT_L(0); PG8_MMA(0, 1, At, B1); PG8_BAR;
            PG8_LDA(At, 1, 1); PG8_STAGE(PG8_SA(1, 0), a3, voffA);
            PG8_BAR; PG8_WAIT_L(0); PG8_MMA(1, 0, At, B0); PG8_BAR; PG8_SCHED;
            PG8_STAGE(PG8_SB(1, 1), b3 + hstep, voffB);
            PG8_WAIT_V(6); PG8_BAR; PG8_MMA(1, 1, At, B1); PG8_BAR;
            }
        }
        if constexpr (ALIGN_EPI) { if (wr == 0) PG8_BAR; }
        if constexpr (!Epi::AFTER_DRAIN) { E(acc, cur, wr, wc, fr, fq); S.done(cur); }
        if (!has_next) break;
#pragma unroll
        for (int a = 0; a < 2; ++a)
#pragma unroll
            for (int b = 0; b < 2; ++b)
#pragma unroll
                for (int m = 0; m < 4; ++m)
#pragma unroll
                    for (int n = 0; n < 2; ++n) acc[a][b][m][n] = (f32x4){0.f, 0.f, 0.f, 0.f};
        cur = nxt; cA = nA; cB = nB; ++ui;
        if constexpr (ALIGN_EPI) { if (wr == 1) PG8_BAR; }
    }
    PG8_WAIT_V(0);
    if constexpr (!ALIGN_EPI) { if (wr == 0) PG8_BAR; }
    PG8_BAR;
    if constexpr (Epi::AFTER_DRAIN) { E.fused(acc, cur, wr, wc, fr, fq, lds, wid, lane); S.done(cur); }
#undef PG8_SA
#undef PG8_SB
#undef PG8_STAGE
#undef PG8_LDA
#undef PG8_LDB
#undef PG8_MMA
#undef PG8_WAIT_V
#undef PG8_WAIT_L
#undef PG8_BAR
#undef PG8_SCHED
}
}

namespace pg8 {
__device__ __forceinline__ float gelu_tanh(float x) {
    const float y = x * (0.7978845608028654f + 0.035677408136300125f * x * x);
    const float e = __builtin_amdgcn_exp2f(y * (-2.0f * 1.4426950408889634f));
    return x * __builtin_amdgcn_rcpf(1.0f + e);
}
template <int ACT> struct EpiAct {
    static constexpr bool PERM = true, AFTER_DRAIN = false;
    bf16_t* O; int ldc; int split_cols; size_t split_stride; int act_tile0;
    __device__ __forceinline__ void operator()(const f32x4 (&acc)[2][2][4][2], const Unit& u, int wr, int wc, int fr, int fq) const {
        const int row0 = u.pm * BM + wr * 64 + fr; int colt = u.pn * BM; bf16_t* base = O;
        if (split_cols) { const int t = colt / split_cols; base += (size_t)t * split_stride; colt -= t * split_cols; }
        const int col0 = colt + wc * 32 + 8 * fq;
        const bool act1 = (ACT == 1) && (u.pn >= act_tile0);
#pragma unroll
        for (int ai = 0; ai < 2; ++ai)
#pragma unroll
            for (int m = 0; m < 4; ++m) { bf16_t* rowp = base + (size_t)(row0 + ai * HALF + m * 16) * ldc + col0;
#pragma unroll
                for (int bj = 0; bj < 2; ++bj) { f32x4 v0 = acc[ai][bj][m][0], v1 = acc[ai][bj][m][1];
                    if (ACT == 1) { if (act1) {
#pragma unroll
                        for (int e = 0; e < 4; ++e) { v0[e] = gelu_tanh(v0[e]); v1[e] = gelu_tanh(v1[e]); } } }
                    if (ACT == 2) {
#pragma unroll
                        for (int e = 0; e < 4; ++e) { const float a = fmaxf(v0[e], 0.f), b = fmaxf(v1[e], 0.f); v0[e] = a * a; v1[e] = b * b; } }
                    u32x4 w; w.x = cvt_pk_bf16(v0[0], v0[1]); w.y = cvt_pk_bf16(v0[2], v0[3]); w.z = cvt_pk_bf16(v1[0], v1[1]); w.w = cvt_pk_bf16(v1[2], v1[3]);
                    *(u32x4*)(rowp + bj * HALF) = w; } }
    }
};
struct EpiRes {
    static constexpr bool PERM = false, AFTER_DRAIN = false;
    const float* base; float* out; int ldc;
    __device__ __forceinline__ void operator()(const f32x4 (&acc)[2][2][4][2], const Unit& u, int wr, int wc, int fr, int fq) const {
        const int row0 = u.pm * BM + wr * 64 + fr, col0 = u.pn * BM + wc * 32 + 4 * fq;
#pragma unroll
        for (int ai = 0; ai < 2; ++ai)
#pragma unroll
            for (int m = 0; m < 4; ++m) { const size_t off = (size_t)(row0 + ai * HALF + m * 16) * ldc + col0;
                f32x4 b[2][2];
#pragma unroll
                for (int bj = 0; bj < 2; ++bj)
#pragma unroll
                    for (int n = 0; n < 2; ++n) b[bj][n] = *(const f32x4*)(base + off + bj * HALF + n * 16);
#pragma unroll
                for (int bj = 0; bj < 2; ++bj)
#pragma unroll
                    for (int n = 0; n < 2; ++n) *(f32x4*)(out + off + bj * HALF + n * 16) = b[bj][n] + acc[ai][bj][m][n];
                asm volatile("" ::: "memory"); }
    }
};
}

#ifndef PG8_SP2
#define PG8_SP2 true
#endif
#ifndef PG8_ALIGN
#define PG8_ALIGN true
#endif
#ifndef MK_PER_PHASE
#define MK_PER_PHASE 0
#endif
constexpr int NWAVES = 8;
constexpr int NB = 2, SEQ = 16384, DM = 2048, M = NB * SEQ, DFF = 8192, NMIX = 5120, NQKV = 6144, NH = 16, HD = 128, BLK = 256, NBLK = SEQ / BLK;
constexpr int CW = 1024, SGW = 1024, SGG = 8, SGD = 128, SGC = 128;
constexpr float EPS = 1e-6f;
constexpr int N_PHASES = 17;
constexpr size_t MiB = 1u << 20;
constexpr size_t WS_CTL = 0, CTL_ZERO_BYTES = 64 * 1024;
constexpr size_t WS_KMP = 1 * MiB;
constexpr size_t WS_SEL = 3 * MiB;
constexpr size_t WS_LS = 5 * MiB;
constexpr size_t WS_WSB = 13 * MiB;
constexpr size_t WS_WIN = 16 * MiB, WS_WOUT = 36 * MiB, WS_WUP0 = 44 * MiB, WS_WDN0 = 76 * MiB, WS_WQKV = 108 * MiB, WS_WO = 132 * MiB, WS_WUP1 = 140 * MiB, WS_WDN1 = 172 * MiB;
constexpr size_t WS_HB = 204 * MiB;
constexpr size_t WS_BIG = 332 * MiB;
constexpr size_t WS_Z = WS_BIG, WS_CAT = WS_BIG + 320 * MiB, WS_HID = WS_BIG, WS_Q = WS_BIG, WS_K = WS_BIG + 128 * MiB, WS_V = WS_BIG + 256 * MiB;
constexpr size_t WS_PO0 = WS_BIG + 384 * MiB, WS_PO1 = WS_BIG + 512 * MiB, WS_PO2 = WS_HB;
constexpr size_t WS_END = WS_PO1 + 128 * MiB;
static_assert(WS_END <= 1024 * MiB, "workspace map");
constexpr int CW_BAR = 1024;
constexpr int RING_OFF = 0, RING_BYTES = 131072, LDSCTL_OFF = RING_BYTES, MISC_OFF = LDSCTL_OFF + 320, LDS_BYTES = 147456;

#define GAS __attribute__((address_space(1)))
#define LAS __attribute__((address_space(3)))
typedef unsigned short bf16;
typedef unsigned v4u __attribute__((ext_vector_type(4)));
typedef float f32x4 __attribute__((ext_vector_type(4)));
typedef short bf16x8 __attribute__((ext_vector_type(8)));
typedef GAS unsigned gu32;
typedef GAS unsigned long long gu64;
#define RLX_AGENT __ATOMIC_RELAXED, __HIP_MEMORY_SCOPE_AGENT
#define LDS_WAIT() asm volatile("s_waitcnt lgkmcnt(0)" ::: "memory")
#define VM_WAIT() asm volatile("s_waitcnt vmcnt(0)" ::: "memory")
__device__ __forceinline__ unsigned long long rt() { return __builtin_amdgcn_s_memrealtime(); }
__device__ __forceinline__ unsigned f2bf(float f) { unsigned u = __builtin_bit_cast(unsigned, f); return (u + 0x7fffu + ((u >> 16) & 1u)) >> 16; }
__device__ __forceinline__ unsigned pk2(float lo, float hi) { return f2bf(lo) | (f2bf(hi) << 16); }

#define XB_TMO      128
#define XB_XCNT(j)  (256  + 64 * (j))
#define XB_XSUB(j)  (1280 + 64 * (j))
#define XB_XGEN(j)  (2304 + 64 * (j))
#define XB_TOP      3328
#define XB_TOPGEN   3392
#define XCD_BAR_WORDS 3456
#define XB_SPIN_CAP (1u << 18)

__device__ __forceinline__ unsigned xb_ld(unsigned* p)              { return __hip_atomic_load(p, __ATOMIC_RELAXED, __HIP_MEMORY_SCOPE_AGENT); }
__device__ __forceinline__ unsigned xb_add(unsigned* p, unsigned v) { return __hip_atomic_fetch_add(p, v, __ATOMIC_RELAXED, __HIP_MEMORY_SCOPE_AGENT); }
__device__ __forceinline__ unsigned xb_xcc_id() { return (unsigned)__builtin_amdgcn_s_getreg((3 << 11) | 20) & 0xFu; }
#define XB_SPIN(cond, bar) do { unsigned _sp = 0; while (cond) { __builtin_amdgcn_s_sleep(1); \
    if ((++_sp & 255u) == 0u) { if (xb_ld(&(bar)[XB_TMO])) break; if (_sp > XB_SPIN_CAP) { atomicAdd(&(bar)[XB_TMO], 1u); break; } } } } while (0)

struct XcdBarrier {
    unsigned* bar; unsigned x;
    volatile LAS unsigned* st;
};

__device__ __forceinline__ XcdBarrier xcd_barrier_post(unsigned* bar, volatile LAS unsigned* st) {
    XcdBarrier b; b.bar = bar; b.x = xb_xcc_id(); b.st = st;
    if (threadIdx.x == 0) (void)xb_add(&bar[XB_XCNT(b.x)], 1u);
    return b;
}
__device__ __forceinline__ void xcd_barrier_complete(unsigned* bar, unsigned x, unsigned& nloc, unsigned& nx) {
    const unsigned G = gridDim.x * gridDim.y * gridDim.z;
    unsigned sum, cnt, mine, sp = 0u;
    for (;;) {
        sum = 0u; cnt = 0u; mine = 0u;
#pragma unroll
        for (unsigned j = 0; j < 16; ++j) { const unsigned c = xb_ld(&bar[XB_XCNT(j)]); sum += c; cnt += (c > 0u) ? 1u : 0u; mine = (j == x) ? c : mine; }
        if (sum == G) break;
        __builtin_amdgcn_s_sleep(1);
        if ((++sp & 255u) == 0u) { if (xb_ld(&bar[XB_TMO])) break; if (sp > XB_SPIN_CAP) { atomicAdd(&bar[XB_TMO], 1u); break; } }
    }
    nloc = mine > 0u ? mine : 1u; nx = cnt > 0u ? cnt : 1u;
}

__device__ __forceinline__ void xcd_barrier(const XcdBarrier& b) {
    asm volatile("s_waitcnt vmcnt(0)" ::: "memory");
    __syncthreads();
    if (threadIdx.x == 0) {
        unsigned* bar = b.bar;
        __builtin_amdgcn_s_waitcnt(0);
        unsigned nloc = b.st[0], nx = b.st[1];
        if (nloc == 0u) { xcd_barrier_complete(bar, b.x, nloc, nx); b.st[0] = nloc; b.st[1] = nx; }
        const unsigned old = xb_add(&bar[XB_XSUB(b.x)], 1u);
        const unsigned gen = old / nloc;
        if (old + 1u == (gen + 1u) * nloc) {
            __builtin_amdgcn_fence(__ATOMIC_RELEASE, "agent");
            asm volatile("s_waitcnt vmcnt(0)" ::: "memory");
            const unsigned og = xb_add(&bar[XB_TOP], 1u);
            const unsigned tg = og / nx;
            if (og + 1u == (tg + 1u) * nx) xb_add(&bar[XB_TOPGEN], 1u);
            else XB_SPIN(xb_ld(&bar[XB_TOPGEN]) == tg, bar);
            __builtin_amdgcn_fence(__ATOMIC_ACQUIRE, "agent");
            xb_add(&bar[XB_XGEN(b.x)], 1u);
            asm volatile("s_waitcnt vmcnt(0)" ::: "memory");
        } else {
            XB_SPIN(xb_ld(&bar[XB_XGEN(b.x)]) == gen, bar);
            __builtin_amdgcn_fence(__ATOMIC_ACQUIRE, "agent");
            asm volatile("s_waitcnt vmcnt(0)" ::: "memory");
        }
    }
    __syncthreads();
}

typedef short s16x4 __attribute__((ext_vector_type(4)));
typedef unsigned u32x2v __attribute__((ext_vector_type(2)));
__device__ __forceinline__ float bf_lo(unsigned w) { return __uint_as_float(w << 16); }
__device__ __forceinline__ float bf_hi(unsigned w) { return __uint_as_float(w & 0xffff0000u); }
__device__ __forceinline__ void unpack8(const v4u w, float (&f)[8]) {
    f[0] = bf_lo(w.x); f[1] = bf_hi(w.x); f[2] = bf_lo(w.y); f[3] = bf_hi(w.y); f[4] = bf_lo(w.z); f[5] = bf_hi(w.z); f[6] = bf_lo(w.w); f[7] = bf_hi(w.w); }
__device__ __forceinline__ v4u pack8(const float (&f)[8]) { v4u w; w.x = pk2(f[0], f[1]); w.y = pk2(f[2], f[3]); w.z = pk2(f[4], f[5]); w.w = pk2(f[6], f[7]); return w; }
__device__ __forceinline__ float wave_sum(float v) {
#pragma unroll
    for (int o = 1; o < 64; o <<= 1) v += __shfl_xor(v, o);
    return v;
}
__device__ __forceinline__ float wave_max(float v) {
#pragma unroll
    for (int o = 1; o < 64; o <<= 1) v = fmaxf(v, __shfl_xor(v, o));
    return v;
}
__device__ __forceinline__ void p0_transpose_item(const float* W, int K, int N, bf16* WT, LAS float* scr, int item, int lane) {
    const int nblk = N / 32, kb = item / nblk, nb = item % nblk, k0 = 64 * kb, n0 = 32 * nb;
#pragma unroll 8
    for (int i = 0; i < 32; ++i) { const int kk = 2 * i + (lane >> 5); scr[kk * 33 + (lane & 31)] = W[(size_t)(k0 + kk) * N + n0 + (lane & 31)]; }
    LDS_WAIT(); asm volatile("" ::: "memory");
    const int c = lane & 7;
#pragma unroll
    for (int j = 0; j < 4; ++j) { const int n = (lane >> 3) + 8 * j; const LAS float* s = scr + (8 * c) * 33 + n;
        v4u o; o.x = pk2(s[0 * 33], s[1 * 33]); o.y = pk2(s[2 * 33], s[3 * 33]); o.z = pk2(s[4 * 33], s[5 * 33]); o.w = pk2(s[6 * 33], s[7 * 33]);
        *(GAS v4u*)(WT + (size_t)(n0 + n) * K + k0 + 8 * c) = o; }
    LDS_WAIT(); asm volatile("" ::: "memory");
}
__device__ __forceinline__ void rms_rows(const float* X, const float* g, bf16* O, int gw, int ngw, int lane) {
    f32x4 gv[8];
#pragma unroll
    for (int j = 0; j < 8; ++j) gv[j] = ((const GAS f32x4*)g)[lane + 64 * j];
    for (int m = gw; m < M; m += ngw) {
        const GAS f32x4* xr = (const GAS f32x4*)(X + (size_t)m * DM) + lane;
        f32x4 v[8]; float s = 0.f;
#pragma unroll
        for (int j = 0; j < 8; ++j) { v[j] = xr[64 * j]; s += (v[j].x * v[j].x + v[j].y * v[j].y) + (v[j].z * v[j].z + v[j].w * v[j].w); }
        const float rinv = 1.0f / sqrtf(wave_sum(s) * (1.0f / DM) + EPS);
        GAS u32x2v* o8 = (GAS u32x2v*)(O + (size_t)m * DM) + lane;
#pragma unroll
        for (int j = 0; j < 8; ++j) { u32x2v w; w.x = pk2(v[j].x * rinv * gv[j].x, v[j].y * rinv * gv[j].y); w.y = pk2(v[j].z * rinv * gv[j].z, v[j].w * rinv * gv[j].w); o8[64 * j] = w; }
    }
}
constexpr int VN_PITCH = 544;
__device__ __forceinline__ void mixer_unit(int unit, const bf16* Z, bf16* CAT, const float* conv_w, const float* sgu_gain, const bf16* WSB, const float* b_s, LAS unsigned char* lds, int tid) {
    const int m0 = unit * SGC, lane = tid & 63, wid = tid >> 6;
    {
        const int cc = tid & 127, rg = tid >> 7, ch0 = 8 * cc;
        float w0[8], w1[8], w2[8];
#pragma unroll
        for (int e = 0; e < 8; ++e) { w0[e] = conv_w[(ch0 + e) * 3 + 0]; w1[e] = conv_w[(ch0 + e) * 3 + 1]; w2[e] = conv_w[(ch0 + e) * 3 + 2]; }
        const int mf = m0 + 32 * rg;
        float ym2[8], ym1[8];
#pragma unroll
        for (int e = 0; e < 8; ++e) { ym2[e] = 0.f; ym1[e] = 0.f; }
        if ((mf % SEQ) >= 2) {
            float a[8], b[8];
            unpack8(*(const GAS v4u*)(Z + (size_t)(mf - 2) * NMIX + CW + ch0), a); unpack8(*(const GAS v4u*)(Z + (size_t)(mf - 2) * NMIX + 2 * CW + ch0), b);
#pragma unroll
            for (int e = 0; e < 8; ++e) ym2[e] = a[e] * b[e];
            unpack8(*(const GAS v4u*)(Z + (size_t)(mf - 1) * NMIX + CW + ch0), a); unpack8(*(const GAS v4u*)(Z + (size_t)(mf - 1) * NMIX + 2 * CW + ch0), b);
#pragma unroll
            for (int e = 0; e < 8; ++e) ym1[e] = a[e] * b[e];
        }
#pragma unroll 4
        for (int t = 0; t < 32; ++t) {
            const size_t m = (size_t)(mf + t);
            float gb[8], gc[8], xa[8], o[8];
            unpack8(*(const GAS v4u*)(Z + m * NMIX + ch0), gb); unpack8(*(const GAS v4u*)(Z + m * NMIX + CW + ch0), gc); unpack8(*(const GAS v4u*)(Z + m * NMIX + 2 * CW + ch0), xa);
#pragma unroll
            for (int e = 0; e < 8; ++e) { const float y = gc[e] * xa[e]; o[e] = gb[e] * (ym2[e] * w0[e] + ym1[e] * w1[e] + y * w2[e]); ym2[e] = ym1[e]; ym1[e] = y; }
            *(GAS v4u*)(CAT + m * DM + ch0) = pack8(o);
        }
    }
    for (int gp = 0; gp < SGG; gp += 2) {
#pragma unroll 2
        for (int k = 0; k < 8; ++k) {
            const int p = tid + 512 * k, j = p >> 5, cp = p & 31;
            float v[8]; unpack8(*(const GAS v4u*)(Z + (size_t)(m0 + j) * NMIX + 4 * CW + gp * SGD + cp * 8), v);
            float ss = 0.f;
#pragma unroll
            for (int e = 0; e < 8; ++e) ss += v[e] * v[e];
            ss += __shfl_xor(ss, 1); ss += __shfl_xor(ss, 2); ss += __shfl_xor(ss, 4); ss += __shfl_xor(ss, 8);
            const float rinv = 1.0f / sqrtf(ss * (1.0f / SGD) + EPS);
            const GAS f32x4* gp4 = (const GAS f32x4*)(sgu_gain + gp * SGD + cp * 8); const f32x4 g0 = gp4[0], g1 = gp4[1];
            float o[8] = {v[0] * rinv * g0.x, v[1] * rinv * g0.y, v[2] * rinv * g0.z, v[3] * rinv * g0.w, v[4] * rinv * g1.x, v[5] * rinv * g1.y, v[6] * rinv * g1.z, v[7] * rinv * g1.w};
            *(LAS v4u*)(lds + j * VN_PITCH + cp * 16) = pack8(o);
        }
        LDS_WAIT(); __syncthreads();
        {
            const int gl = wid >> 2, g = gp + gl, dq = wid & 3;
            const int G4 = lane >> 4, q4 = (lane >> 2) & 3, p4 = lane & 3, fr = lane & 15;
            bf16x8 af[2][4];
#pragma unroll
            for (int dt = 0; dt < 2; ++dt)
#pragma unroll
                for (int ks = 0; ks < 4; ++ks) {
                    const unsigned addr = (unsigned)(uintptr_t)(lds) + (unsigned)((32 * ks + 8 * G4 + q4) * VN_PITCH + (gl * SGD + 16 * (2 * dq + dt) + 4 * p4) * 2);
                    s16x4 lo, hi;
                    asm volatile("ds_read_b64_tr_b16 %0, %1" : "=&v"(lo) : "v"(addr) : "memory");
                    asm volatile("ds_read_b64_tr_b16 %0, %1 offset:%2" : "=&v"(hi) : "v"(addr), "i"(4 * VN_PITCH) : "memory");
                    asm volatile("s_waitcnt lgkmcnt(0)" ::: "memory");
                    af[dt][ks] = (bf16x8){lo[0], lo[1], lo[2], lo[3], hi[0], hi[1], hi[2], hi[3]};
                }
            __builtin_amdgcn_sched_barrier(0);
#pragma unroll
            for (int it = 0; it < 8; ++it) {
                const int nks = it / 2 + 1;
                bf16x8 bfr[4];
#pragma unroll
                for (int ks = 0; ks < 4; ++ks) if (ks < nks) bfr[ks] = *(const GAS bf16x8*)(WSB + ((size_t)(g * 128 + 16 * it + fr) * 128 + 32 * ks + 8 * G4));
                const int mt = m0 + 16 * it + fr;
                const float bias = b_s[g * SGC + 16 * it + fr];
#pragma unroll
                for (int dt = 0; dt < 2; ++dt) {
                    f32x4 acc = {0.f, 0.f, 0.f, 0.f};
#pragma unroll
                    for (int ks = 0; ks < 4; ++ks) if (ks < nks) acc = __builtin_amdgcn_mfma_f32_16x16x32_bf16(af[dt][ks], bfr[ks], acc, 0, 0, 0);
                    const int dabs = g * SGD + 16 * (2 * dq + dt) + 4 * G4;
                    const u32x2v uw = *(const GAS u32x2v*)(Z + (size_t)mt * NMIX + 3 * CW + dabs);
                    u32x2v ow; ow.x = pk2(bf_lo(uw.x) * (acc[0] + bias), bf_hi(uw.x) * (acc[1] + bias)); ow.y = pk2(bf_lo(uw.y) * (acc[2] + bias), bf_hi(uw.y) * (acc[3] + bias));
                    *(GAS u32x2v*)(CAT + (size_t)mt * DM + CW + dabs) = ow;
                }
            }
        }
        __syncthreads();
    }
}
__device__ __forceinline__ void qknorm_unit(int unit, bf16* Q, bf16* K, const float* q_gain, const float* k_gain, float* KMP, LAS unsigned char* lds, int tid) {
    const int m0 = unit * 128, cc = tid & 255, rg = tid >> 8, col = 8 * cc, d0 = col & (HD - 1), h = col >> 7;
    float gq[8], gk[8], ksum[8];
#pragma unroll
    for (int e = 0; e < 8; ++e) { gq[e] = q_gain[d0 + e]; gk[e] = k_gain[d0 + e]; ksum[e] = 0.f; }
#pragma unroll 4
    for (int r = 0; r < 64; ++r) {
        const size_t off = (size_t)(m0 + 64 * rg + r) * DM + col;
        float q[8], k[8]; unpack8(*(const GAS v4u*)(Q + off), q); unpack8(*(const GAS v4u*)(K + off), k);
        float sq = 0.f, sk = 0.f;
#pragma unroll
        for (int e = 0; e < 8; ++e) { sq += q[e] * q[e]; sk += k[e] * k[e]; }
        sq += __shfl_xor(sq, 1); sk += __shfl_xor(sk, 1); sq += __shfl_xor(sq, 2); sk += __shfl_xor(sk, 2); sq += __shfl_xor(sq, 4); sk += __shfl_xor(sk, 4); sq += __shfl_xor(sq, 8); sk += __shfl_xor(sk, 8);
        const float rq = 1.0f / sqrtf(sq * (1.0f / HD) + EPS), rk = 1.0f / sqrtf(sk * (1.0f / HD) + EPS);
#pragma unroll
        for (int e = 0; e < 8; ++e) { q[e] = q[e] * rq * gq[e]; k[e] = k[e] * rk * gk[e]; ksum[e] += k[e]; }
        *(GAS v4u*)(Q + off) = pack8(q); *(GAS v4u*)(K + off) = pack8(k);
    }
    LAS float* red = (LAS float*)lds;
    if (rg == 1) {
#pragma unroll
        for (int e = 0; e < 8; ++e) red[cc * 8 + e] = ksum[e];
    }
    LDS_WAIT(); __syncthreads();
    if (rg == 0) {
        const int b = m0 / SEQ, blk = (m0 % SEQ) / BLK, half = (m0 / 128) & 1;
        float* dst = KMP + ((((size_t)(b * NH + h) * NBLK + blk) * 2 + half) * HD + d0);
        f32x4 o0, o1;
        o0.x = (ksum[0] + red[cc * 8 + 0]) * (1.0f / BLK); o0.y = (ksum[1] + red[cc * 8 + 1]) * (1.0f / BLK); o0.z = (ksum[2] + red[cc * 8 + 2]) * (1.0f / BLK); o0.w = (ksum[3] + red[cc * 8 + 3]) * (1.0f / BLK);
        o1.x = (ksum[4] + red[cc * 8 + 4]) * (1.0f / BLK); o1.y = (ksum[5] + red[cc * 8 + 5]) * (1.0f / BLK); o1.z = (ksum[6] + red[cc * 8 + 6]) * (1.0f / BLK); o1.w = (ksum[7] + red[cc * 8 + 7]) * (1.0f / BLK);
        *(GAS f32x4*)dst = o0; *(GAS f32x4*)(dst + 4) = o1;
    }
    __syncthreads();
}

namespace att {
typedef float f32x16 __attribute__((ext_vector_type(16)));
constexpr float SCALE = 0.08838834764831845f, LOG2E = 1.4426950408889634f, CS = SCALE * LOG2E;
constexpr int KT = 16384;
constexpr int LDS_K = 0, LDS_V = 2 * KT, LDS_LIST = 4 * KT, LDS_CNT = LDS_LIST + 32768;
#define KSWZ(row, colB) ((row) * 256 + ((colB) ^ (((row) & 7) << 4)))
#define SBAR() __builtin_amdgcn_sched_barrier(0)
__device__ __forceinline__ int crow(int r, int hi) { return (r & 3) + 8 * (r >> 2) + 4 * hi; }
__device__ __forceinline__ unsigned cvtpk(float lo, float hi) { unsigned r; asm volatile("v_cvt_pk_bf16_f32 %0, %1, %2" : "=v"(r) : "v"(lo), "v"(hi)); return r; }
__device__ __forceinline__ int v_st(int k, int c) { const int kk = (k & ~0xC) | ((k & 4) << 1) | ((k & 8) >> 1); return ((kk >> 3) * 4 + (c >> 5)) * 512 + ((kk & 7) * 32 + (c & 31)) * 2; }
__device__ __forceinline__ int v_rd_base(int lane) { return ((lane & 3) << 3) | (((lane >> 2) & 3) << 6) | (((lane >> 4) & 1) << 5) | (((lane >> 5) & 1) << 8); }
constexpr int v_rd_off(int d0, int ks, int half) { return d0 * 512 + ks * 4096 + half * 2048; }
template <int OFF> __device__ __forceinline__ s16x4 tr_read(int vb) { s16x4 r; asm volatile("ds_read_b64_tr_b16 %0, %1 offset:%2" : "=&v"(r) : "v"(vb), "i"(OFF) : "memory"); return r; }
__device__ __forceinline__ void qkt(f32x16& p0, f32x16& p1, const LAS unsigned char* Ks, const bf16x8 (&qr)[8], int r32, int hi) {
    p0 = (f32x16){}; p1 = (f32x16){};
#pragma unroll
    for (int d0 = 0; d0 < 8; ++d0) { const int cb = (d0 * 16 + hi * 8) * 2;
        const bf16x8 b0 = *(const LAS bf16x8*)(Ks + KSWZ(r32, cb));
        const bf16x8 b1 = *(const LAS bf16x8*)(Ks + KSWZ(32 + r32, cb));
        p0 = __builtin_amdgcn_mfma_f32_32x32x16_bf16(b0, qr[d0], p0, 0, 0, 0);
        p1 = __builtin_amdgcn_mfma_f32_32x32x16_bf16(b1, qr[d0], p1, 0, 0, 0); }
}
template <int D0> __device__ __forceinline__ void pv_one(f32x16& od, int vb, bf16x8 pa0, bf16x8 pa1, bf16x8 pa2, bf16x8 pa3) {
    const s16x4 l0 = tr_read<v_rd_off(D0, 0, 0)>(vb), h0 = tr_read<v_rd_off(D0, 0, 1)>(vb), l1 = tr_read<v_rd_off(D0, 1, 0)>(vb), h1 = tr_read<v_rd_off(D0, 1, 1)>(vb);
    const s16x4 l2 = tr_read<v_rd_off(D0, 2, 0)>(vb), h2 = tr_read<v_rd_off(D0, 2, 1)>(vb), l3 = tr_read<v_rd_off(D0, 3, 0)>(vb), h3 = tr_read<v_rd_off(D0, 3, 1)>(vb);
    asm volatile("s_waitcnt lgkmcnt(0)" ::: "memory"); SBAR();
#define PK(L, H) (bf16x8){L[0], L[1], L[2], L[3], H[0], H[1], H[2], H[3]}
    od = __builtin_amdgcn_mfma_f32_32x32x16_bf16(PK(l0, h0), pa0, od, 0, 0, 0);
    od = __builtin_amdgcn_mfma_f32_32x32x16_bf16(PK(l1, h1), pa1, od, 0, 0, 0);
    od = __builtin_amdgcn_mfma_f32_32x32x16_bf16(PK(l2, h2), pa2, od, 0, 0, 0);
    od = __builtin_amdgcn_mfma_f32_32x32x16_bf16(PK(l3, h3), pa3, od, 0, 0, 0);
#undef PK
}
template <bool MASK> __device__ __forceinline__ void tile_step(f32x16 (&oT)[4], float& lsum, const LAS unsigned char* Ks, int vb, const bf16x8 (&qr)[8], float qterm, float sl2, int qrel, int r32, int hi) {
    f32x16 p0, p1; qkt(p0, p1, Ks, qr, r32, hi);
    const float base = qterm + sl2 * (float)(4 * hi);
    float ps = 0.f;
#pragma unroll
    for (int r = 0; r < 16; ++r) { const int kk = (r & 3) + 8 * (r >> 2);
        float a0 = fmaf(p0[r], CS, fmaf(sl2, (float)kk, base)), a1 = fmaf(p1[r], CS, fmaf(sl2, (float)(kk + 32), base));
        if (MASK) { const unsigned m0_ = (unsigned)((qrel - (kk + 4 * hi)) >> 31), m1_ = (unsigned)((qrel - (kk + 4 * hi + 32)) >> 31);
            a0 = __uint_as_float((__float_as_uint(a0) & ~m0_) | (0xff800000u & m0_)); a1 = __uint_as_float((__float_as_uint(a1) & ~m1_) | (0xff800000u & m1_)); }
        p0[r] = __builtin_amdgcn_exp2f(a0); p1[r] = __builtin_amdgcn_exp2f(a1); ps += p0[r] + p1[r]; }
    lsum += ps;
    bf16x8 pa0, pa1, pa2, pa3;
#define PK4(P, BASE, OUT) do { unsigned a0_ = cvtpk(P[BASE + 0], P[BASE + 1]), a1_ = cvtpk(P[BASE + 2], P[BASE + 3]);   \
    unsigned b0_ = cvtpk(P[BASE + 4], P[BASE + 5]), b1_ = cvtpk(P[BASE + 6], P[BASE + 7]);                              \
    auto r0_ = __builtin_amdgcn_permlane32_swap(a0_, b0_, false, false); auto r1_ = __builtin_amdgcn_permlane32_swap(a1_, b1_, false, false); \
    v4u w_ = {r0_[0], r1_[0], r0_[1], r1_[1]}; OUT = __builtin_bit_cast(bf16x8, w_); } while (0)
    PK4(p0, 0, pa0); PK4(p0, 8, pa1); PK4(p1, 0, pa2); PK4(p1, 8, pa3);
#undef PK4
    pv_one<0>(oT[0], vb, pa0, pa1, pa2, pa3); pv_one<1>(oT[1], vb, pa0, pa1, pa2, pa3); pv_one<2>(oT[2], vb, pa0, pa1, pa2, pa3); pv_one<3>(oT[3], vb, pa0, pa1, pa2, pa3);
}
struct Stg { v4u k0, k1, v0, v1; };
__device__ __forceinline__ void stage_load(Stg& s, const bf16* Kg, const bf16* Vg, size_t krow0, int hc, int tid) {
    const int sr = tid >> 4, sc = (tid & 15) * 8;
    const size_t o0 = (krow0 + sr) * DM + hc + sc, o1 = (krow0 + 32 + sr) * DM + hc + sc;
    s.k0 = *(const GAS v4u*)(Kg + o0); s.k1 = *(const GAS v4u*)(Kg + o1); s.v0 = *(const GAS v4u*)(Vg + o0); s.v1 = *(const GAS v4u*)(Vg + o1);
}
__device__ __forceinline__ void stage_write(const Stg& s, LAS unsigned char* Kb, LAS unsigned char* Vb, int tid) {
    const int sr = tid >> 4, sc = (tid & 15) * 8;
    *(LAS v4u*)(Kb + KSWZ(sr, sc * 2)) = s.k0; *(LAS v4u*)(Kb + KSWZ(32 + sr, sc * 2)) = s.k1;
    *(LAS v4u*)(Vb + v_st(sr, sc)) = s.v0; *(LAS v4u*)(Vb + v_st(32 + sr, sc)) = s.v1;
}
template <bool CAUSAL> __device__ __forceinline__ void block_attend(f32x16 (&oT)[4], float& lsum, const bf16* Kg, const bf16* Vg, size_t krow0, int hc, const bf16x8 (&qr)[8],
                                             int t_minus_kb, int qin, int ntile_w, float sl2, float mref2, LAS unsigned char* lds, int tid, int r32, int hi, int lane) {
    Stg s;
    stage_load(s, Kg, Vg, krow0, hc, tid);
    stage_write(s, lds + LDS_K, lds + LDS_V, tid);
    LDS_WAIT(); __syncthreads();
#pragma unroll 1
    for (int t = 0; t < 4; ++t) {
        const int cur = (t & 1) * KT, nxt = KT - cur;
        if (t < 3) stage_load(s, Kg, Vg, krow0 + 64 * (t + 1), hc, tid);
        if (t < ntile_w) {
            const float qterm = -sl2 * (float)(t_minus_kb - 64 * t) - mref2;
            tile_step<CAUSAL>(oT, lsum, lds + LDS_K + cur, (int)(unsigned)(uintptr_t)(lds + LDS_V + cur) + v_rd_base(lane), qr, qterm, sl2, qin - 64 * t, r32, hi);
        }
        if (t < 3) stage_write(s, lds + LDS_K + nxt, lds + LDS_V + nxt, tid);
        LDS_WAIT(); __syncthreads();
    }
}
#define INS3(v, n) do { const bool a_ = (v) > v0, b_ = (v) > v1, c_ = (v) > v2; \
    v2 = b_ ? v1 : (c_ ? (v) : v2); n2 = b_ ? n1 : (c_ ? (n) : n2); v1 = a_ ? v0 : (b_ ? (v) : v1); n1 = a_ ? n0 : (b_ ? (n) : n1); v0 = a_ ? (v) : v0; n0 = a_ ? (n) : n0; } while (0)
__device__ __forceinline__ void gate_unit(int b, int h, int i, const bf16* Q, const float* KMP, unsigned* SEL, LAS unsigned char* lds, int tid) {
    const int lane = tid & 63, wid = __builtin_amdgcn_readfirstlane(tid >> 6), r32 = lane & 31, hi = lane >> 5;
    unsigned* selp = SEL + ((size_t)(b * NH + h) * SEQ + i * BLK + wid * 32 + r32);
    if (i == 0) { if (hi == 0) *selp = 0x00ffffffu; return; }
    {
        const int n = tid >> 3, dc = (tid & 7) * 16;
        float hv[16], lv[16];
        if (n < i) {
            const float* p0 = KMP + (((size_t)(b * NH + h) * NBLK + n) * 2) * HD + dc;
#pragma unroll
            for (int e = 0; e < 16; e += 4) { const f32x4 a = *(const GAS f32x4*)(p0 + e), c = *(const GAS f32x4*)(p0 + HD + e);
                const float m0 = a.x + c.x, m1 = a.y + c.y, m2 = a.z + c.z, m3 = a.w + c.w;
                hv[e] = m0; hv[e + 1] = m1; hv[e + 2] = m2; hv[e + 3] = m3; }
#pragma unroll
            for (int e = 0; e < 16; ++e) { const float hb = __uint_as_float(f2bf(hv[e]) << 16); lv[e] = hv[e] - hb; hv[e] = hb; }
        } else {
#pragma unroll
            for (int e = 0; e < 16; ++e) { hv[e] = 0.f; lv[e] = 0.f; }
        }
        float t8[8];
#pragma unroll
        for (int pc = 0; pc < 2; ++pc) {
#pragma unroll
            for (int e = 0; e < 8; ++e) t8[e] = hv[pc * 8 + e];
            *(LAS v4u*)(lds + KSWZ(n, (dc + pc * 8) * 2)) = pack8(t8);
#pragma unroll
            for (int e = 0; e < 8; ++e) t8[e] = lv[pc * 8 + e];
            *(LAS v4u*)(lds + KT + KSWZ(n, (dc + pc * 8) * 2)) = pack8(t8);
        }
    }
    LDS_WAIT(); __syncthreads();
    bf16x8 qr[8];
    { const bf16* qp = Q + (size_t)(b * SEQ + i * BLK + wid * 32 + r32) * DM + h * HD + hi * 8;
#pragma unroll
      for (int d0 = 0; d0 < 8; ++d0) qr[d0] = *(const GAS bf16x8*)(qp + d0 * 16); }
    f32x16 g0, g1, l0, l1;
    qkt(g0, g1, lds, qr, r32, hi); qkt(l0, l1, lds + KT, qr, r32, hi);
    float v0 = -INFINITY, v1 = -INFINITY, v2 = -INFINITY; int n0 = 255, n1 = 255, n2 = 255;
#pragma unroll
    for (int r = 0; r < 16; ++r) { const int n = crow(r, hi); const float g = (n < i) ? g0[r] + l0[r] : -INFINITY; INS3(g, n); }
#pragma unroll
    for (int r = 0; r < 16; ++r) { const int n = 32 + crow(r, hi); const float g = (n < i) ? g1[r] + l1[r] : -INFINITY; INS3(g, n); }
    {
        const float pv0 = __shfl_xor(v0, 32), pv1 = __shfl_xor(v1, 32), pv2 = __shfl_xor(v2, 32);
        const int pn0 = __shfl_xor(n0, 32), pn1 = __shfl_xor(n1, 32), pn2 = __shfl_xor(n2, 32);
        INS3(pv0, pn0); INS3(pv1, pn1); INS3(pv2, pn2);
    }
    if (hi == 0) *selp = (unsigned)n0 | ((unsigned)n1 << 8) | ((unsigned)n2 << 16);
    __syncthreads();
}
#undef INS3
__device__ __forceinline__ void sel_unit(int b, int h, int j, const bf16* Q, const bf16* K, const bf16* V, const unsigned* SEL, bf16* PO0, bf16* PO1, bf16* PO2, float* LS,
                                         float sl2, float mref2, LAS unsigned char* lds, int tid) {
    const int lane = tid & 63, wid = __builtin_amdgcn_readfirstlane(tid >> 6), r32 = lane & 31, hi = lane >> 5;
    LAS unsigned* cnt = (LAS unsigned*)(lds + LDS_CNT);
    LAS unsigned short* list = (LAS unsigned short*)(lds + LDS_LIST);
    if (tid == 0) *cnt = 0u;
    LDS_WAIT(); __syncthreads();
    const unsigned* selp = SEL + (size_t)(b * NH + h) * SEQ;
    const int s_first = BLK * (j + 1);
    const int nscan = SEQ - s_first;
    for (int base = 0; base < nscan; base += 512) {
        const int s = s_first + base + tid;
        int slot = -1;
        if (base + tid < nscan) { const unsigned e = selp[s]; slot = ((e & 255u) == (unsigned)j) ? 0 : ((((e >> 8) & 255u) == (unsigned)j) ? 1 : ((((e >> 16) & 255u) == (unsigned)j) ? 2 : -1)); }
        const unsigned long long mask = __ballot(slot >= 0);
        if (mask) {
            unsigned base_pos = 0;
            if (lane == 0) base_pos = __hip_atomic_fetch_add(cnt, (unsigned)__popcll(mask), __ATOMIC_RELAXED, __HIP_MEMORY_SCOPE_WORKGROUP);
            base_pos = __builtin_amdgcn_readfirstlane(base_pos);
            if (slot >= 0) { const unsigned pos = base_pos + __builtin_amdgcn_mbcnt_hi((unsigned)(mask >> 32), __builtin_amdgcn_mbcnt_lo((unsigned)mask, 0u)); list[pos] = (unsigned short)(s | (slot << 14)); }
        }
    }
    LDS_WAIT(); __syncthreads();
    const int L = (int)*cnt;
    const size_t krow0 = (size_t)b * SEQ + (size_t)j * BLK;
    for (int c0 = 0; c0 < L; c0 += 256) {
        const int idx = c0 + wid * 32 + r32; const bool valid = idx < L;
        const unsigned ent = list[valid ? idx : 0];
        const int s = ent & 0x3fff, slot = ent >> 14;
        const size_t m = (size_t)b * SEQ + s;
        bf16x8 qr[8];
        { const bf16* qp = Q + m * DM + h * HD + hi * 8;
#pragma unroll
          for (int d0 = 0; d0 < 8; ++d0) qr[d0] = *(const GAS bf16x8*)(qp + d0 * 16); }
        f32x16 oT[4]; oT[0] = (f32x16){}; oT[1] = (f32x16){}; oT[2] = (f32x16){}; oT[3] = (f32x16){};
        float lsum = 0.f;
        block_attend<false>(oT, lsum, K, V, krow0, h * HD, qr, s - j * BLK, 0, 4, sl2, mref2, lds, tid, r32, hi, lane);
        lsum += __shfl_xor(lsum, 32);
        if (valid) {
            bf16* po = (slot == 0 ? PO0 : (slot == 1 ? PO1 : PO2)) + m * DM + h * HD + 4 * hi;
#pragma unroll
            for (int d0 = 0; d0 < 4; ++d0)
#pragma unroll
                for (int g = 0; g < 4; ++g) { u32x2v w; w.x = cvtpk(oT[d0][4 * g], oT[d0][4 * g + 1]); w.y = cvtpk(oT[d0][4 * g + 2], oT[d0][4 * g + 3]);
                    *(GAS u32x2v*)(po + 32 * d0 + 8 * g) = w; }
            if (hi == 0) LS[(m * NH + h) * 4 + slot] = lsum;
        }
    }
    __syncthreads();
}
__device__ __forceinline__ void own_unit(int b, int h, int i, const bf16* Q, const bf16* K, const bf16* V, const bf16* PO0, const bf16* PO1, const bf16* PO2, const float* LS, bf16* AO,
                                         float sl2, float mref2, LAS unsigned char* lds, int tid) {
    const int lane = tid & 63, wid = __builtin_amdgcn_readfirstlane(tid >> 6), r32 = lane & 31, hi = lane >> 5;
    const size_t krow0 = (size_t)b * SEQ + (size_t)i * BLK, m = krow0 + wid * 32 + r32;
    bf16x8 qr[8];
    { const bf16* qp = Q + m * DM + h * HD + hi * 8;
#pragma unroll
      for (int d0 = 0; d0 < 8; ++d0) qr[d0] = *(const GAS bf16x8*)(qp + d0 * 16); }
    f32x16 oT[4]; oT[0] = (f32x16){}; oT[1] = (f32x16){}; oT[2] = (f32x16){}; oT[3] = (f32x16){};
    float lsum = 0.f;
    int qin = wid * 32 + r32; asm volatile("" : "+v"(qin));
    block_attend<true>(oT, lsum, K, V, krow0, h * HD, qr, qin, qin, (wid >> 1) + 1, sl2, mref2, lds, tid, r32, hi, lane);
    lsum += __shfl_xor(lsum, 32);
    const int nsel = i < 3 ? i : 3;
#pragma unroll 1
    for (int sl = 0; sl < nsel; ++sl) {
        const bf16* po = (sl == 0 ? PO0 : (sl == 1 ? PO1 : PO2)) + m * DM + h * HD + 4 * hi;
        lsum += LS[(m * NH + h) * 4 + sl];
#pragma unroll
        for (int d0 = 0; d0 < 4; ++d0)
#pragma unroll
            for (int g = 0; g < 4; ++g) { const u32x2v w = *(const GAS u32x2v*)(po + 32 * d0 + 8 * g);
                oT[d0][4 * g] += bf_lo(w.x); oT[d0][4 * g + 1] += bf_hi(w.x); oT[d0][4 * g + 2] += bf_lo(w.y); oT[d0][4 * g + 3] += bf_hi(w.y); }
    }
    const float rl = 1.0f / lsum;
    bf16* ao = AO + m * DM + h * HD + 4 * hi;
#pragma unroll
    for (int d0 = 0; d0 < 4; ++d0)
#pragma unroll
        for (int g = 0; g < 4; ++g) { u32x2v w; w.x = cvtpk(oT[d0][4 * g] * rl, oT[d0][4 * g + 1] * rl); w.y = cvtpk(oT[d0][4 * g + 2] * rl, oT[d0][4 * g + 3] * rl);
            *(GAS u32x2v*)(ao + 32 * d0 + 8 * g) = w; }
}
}

struct Args { const float* in[15]; float* out; unsigned char* ws; int ph_lo, ph_hi; };
__global__ void __launch_bounds__(NWAVES * 64, 2) fwd(Args args) {
    extern __shared__ __attribute__((aligned(16))) unsigned char lds_raw[];
    LAS unsigned char* lds = (LAS unsigned char*)lds_raw;
    volatile LAS unsigned* MISC = (volatile LAS unsigned*)(lds + MISC_OFF);
    const int tid = threadIdx.x, lane = tid & 63, wave = __builtin_amdgcn_readfirstlane(tid >> 6);
    const int G = gridDim.x, bx = blockIdx.x;
    const int vcu = (G % 8 == 0) ? (bx % 8) * (G / 8) + bx / 8 : bx;
    const int gw = vcu * NWAVES + wave, NGW = G * NWAVES;
    unsigned char* ws = args.ws;
    gu32* ctl = (gu32*)(ws + WS_CTL);
    const float* x = args.in[0]; const float* mix_norm = args.in[1]; const float* ffn_norm = args.in[2]; const float* w_in = args.in[3]; const float* conv_w = args.in[4];
    const float* sgu_gain = args.in[5]; const float* w_s = args.in[6]; const float* b_s = args.in[7]; const float* w_mix_out = args.in[8]; const float* w_qkv = args.in[9];
    const float* q_gain = args.in[10]; const float* k_gain = args.in[11]; const float* w_attn_out = args.in[12]; const float* w_up = args.in[13]; const float* w_down = args.in[14];
    float* out = args.out;
    bf16* WIN = (bf16*)(ws + WS_WIN); bf16* WOUT = (bf16*)(ws + WS_WOUT); bf16* WUP0 = (bf16*)(ws + WS_WUP0); bf16* WDN0 = (bf16*)(ws + WS_WDN0);
    bf16* WQKV = (bf16*)(ws + WS_WQKV); bf16* WO = (bf16*)(ws + WS_WO); bf16* WUP1 = (bf16*)(ws + WS_WUP1); bf16* WDN1 = (bf16*)(ws + WS_WDN1);
    bf16* HB = (bf16*)(ws + WS_HB); bf16* Z = (bf16*)(ws + WS_Z); bf16* CAT = (bf16*)(ws + WS_CAT); bf16* HID = (bf16*)(ws + WS_HID);
    bf16* QB = (bf16*)(ws + WS_Q); bf16* KB = (bf16*)(ws + WS_K); bf16* VB = (bf16*)(ws + WS_V);
    bf16* PO0 = (bf16*)(ws + WS_PO0); bf16* PO1 = (bf16*)(ws + WS_PO1); bf16* PO2 = (bf16*)(ws + WS_PO2);
    bf16* WSB = (bf16*)(ws + WS_WSB); float* KMP = (float*)(ws + WS_KMP); unsigned* SEL = (unsigned*)(ws + WS_SEL); float* LS = (float*)(ws + WS_LS);

    for (int u = tid; u < (LDS_BYTES - LDSCTL_OFF) / 4; u += NWAVES * 64) ((LAS unsigned*)(lds + LDSCTL_OFF))[u] = 0u;
    __syncthreads();
    XcdBarrier bar; bar.bar = (unsigned*)(ctl + CW_BAR); bar.x = 0; bar.st = nullptr;
    if (!MK_PER_PHASE) bar = xcd_barrier_post((unsigned*)(ctl + CW_BAR), MISC + 8);
    const int lo = args.ph_lo, hi = args.ph_hi;
#ifndef PH_MASK
#define PH_MASK 0x1ffff
#endif
#define IN(k) ((((PH_MASK) >> (k)) & 1) && lo <= (k) && (k) < hi)
#define SEAM(k) do { if (!MK_PER_PHASE && IN(k) && IN((k) + 1)) xcd_barrier(bar); } while (0)

    if (IN(0)) {
        LAS float* scr = (LAS float*)(lds + RING_OFF + wave * 16384);
        constexpr int I_IN = (DM / 64) * (NMIX / 32), I_SQ = (DM / 64) * (DM / 32), I_UP = (DM / 64) * (DFF / 32), I_DN = (DFF / 64) * (DM / 32), I_QKV = (DM / 64) * (NQKV / 32);
        constexpr int NITEMS = I_IN + 2 * I_SQ + 2 * I_UP + 2 * I_DN + I_QKV;
        for (int it = gw; it < NITEMS; it += NGW) {
            int r = it;
            if (r < I_IN) { p0_transpose_item(w_in, DM, NMIX, WIN, scr, r, lane); continue; } r -= I_IN;
            if (r < I_SQ) { p0_transpose_item(w_mix_out, DM, DM, WOUT, scr, r, lane); continue; } r -= I_SQ;
            if (r < I_UP) { p0_transpose_item(w_up, DM, DFF, WUP0, scr, r, lane); continue; } r -= I_UP;
            if (r < I_DN) { p0_transpose_item(w_down, DFF, DM, WDN0, scr, r, lane); continue; } r -= I_DN;
            if (r < I_QKV) { p0_transpose_item(w_qkv, DM, NQKV, WQKV, scr, r, lane); continue; } r -= I_QKV;
            if (r < I_SQ) { p0_transpose_item(w_attn_out, DM, DM, WO, scr, r, lane); continue; } r -= I_SQ;
            if (r < I_UP) { p0_transpose_item(w_up + (size_t)DM * DFF, DM, DFF, WUP1, scr, r, lane); continue; } r -= I_UP;
            p0_transpose_item(w_down + (size_t)DFF * DM, DFF, DM, WDN1, scr, r, lane);
        }
        for (int e = (bx * NWAVES * 64 + tid) * 4; e < SGG * 128 * 128; e += G * NWAVES * 64 * 4) {
            const int i = (e >> 7) & 127, j = e & 127; const f32x4 v = *(const GAS f32x4*)(w_s + e);
            u32x2v w; w.x = pk2(j <= i ? v.x : 0.f, j + 1 <= i ? v.y : 0.f); w.y = pk2(j + 2 <= i ? v.z : 0.f, j + 3 <= i ? v.w : 0.f);
            *(GAS u32x2v*)(WSB + e) = w;
        }
        rms_rows(x, mix_norm, HB, gw, NGW, lane);
    }
    SEAM(0);
    if (IN(1)) {
        pg8::Gemm g{HB, WIN, M, NMIX, DM}; pg8::StaticOrder S; S.init(M, NMIX, G, bx);
        pg8::EpiAct<1> E{Z, NMIX, 0, 0, 3 * CW / 256};
        pg8::gemm_phase<pg8::EpiAct<1>, pg8::StaticOrder, PG8_ALIGN, PG8_SP2>(lds + RING_OFF, g, S, E);
    }
    SEAM(1);
    if (IN(2)) { for (int u = vcu; u < M / SGC; u += G) mixer_unit(u, Z, CAT, conv_w, sgu_gain, WSB, b_s, lds + RING_OFF, tid); }
    SEAM(2);
    if (IN(3)) {
        pg8::Gemm g{CAT, WOUT, M, DM, DM}; pg8::StaticOrder S; S.init(M, DM, G, bx);
        pg8::EpiRes E{x, out, DM};
        pg8::gemm_phase<pg8::EpiRes, pg8::StaticOrder, PG8_ALIGN, PG8_SP2>(lds + RING_OFF, g, S, E);
    }
    SEAM(3);
    if (IN(4)) rms_rows(out, ffn_norm, HB, gw, NGW, lane);
    SEAM(4);
    if (IN(5)) {
        pg8::Gemm g{HB, WUP0, M, DFF, DM}; pg8::StaticOrder S; S.init(M, DFF, G, bx);
        pg8::EpiAct<2> E{HID, DFF, 0, 0, 0};
        pg8::gemm_phase<pg8::EpiAct<2>, pg8::StaticOrder, PG8_ALIGN, PG8_SP2>(lds + RING_OFF, g, S, E);
    }
    SEAM(5);
    if (IN(6)) {
        pg8::Gemm g{HID, WDN0, M, DM, DFF}; pg8::StaticOrder S; S.init(M, DM, G, bx);
        pg8::EpiRes E{out, out, DM};
        pg8::gemm_phase<pg8::EpiRes, pg8::StaticOrder, PG8_ALIGN, PG8_SP2>(lds + RING_OFF, g, S, E);
    }
    SEAM(6);
    if (IN(7)) rms_rows(out, mix_norm + DM, HB, gw, NGW, lane);
    SEAM(7);
    if (IN(8)) {
        pg8::Gemm g{HB, WQKV, M, NQKV, DM}; pg8::StaticOrder S; S.init(M, NQKV, G, bx);
        pg8::EpiAct<0> E{QB, DM, DM, (size_t)M * DM, 0};
        pg8::gemm_phase<pg8::EpiAct<0>, pg8::StaticOrder, PG8_ALIGN, PG8_SP2>(lds + RING_OFF, g, S, E);
    }
    SEAM(8);
    if (IN(9)) { for (int u = vcu; u < M / 128; u += G) qknorm_unit(u, QB, KB, q_gain, k_gain, KMP, lds + RING_OFF, tid); }
    SEAM(9);
    float mref2;
    { const float gqm = wave_max(fmaxf(fabsf(q_gain[lane]), fabsf(q_gain[lane + 64]))), gkm = wave_max(fmaxf(fabsf(k_gain[lane]), fabsf(k_gain[lane + 64])));
      mref2 = 11.313708498984761f * gqm * gkm * att::LOG2E; }
    if (IN(10)) { for (int u = bx; u < NB * NH * NBLK; u += G) { const int bh = u % (NB * NH), i = u / (NB * NH); att::gate_unit(bh / NH, bh % NH, i, QB, KMP, SEL, lds + RING_OFF, tid); } }
    SEAM(10);
    if (IN(11)) {
        for (int u = bx; u < NB * NH * NBLK; u += G) { const int bh = u % (NB * NH), jr = u / (NB * NH); const int j = ((u >> 8) & 1) ? (jr | 7) - (jr & 7) : jr;
            const int h = bh % NH; const float sl2 = __builtin_amdgcn_exp2f(-0.5f * (float)(h + 1)) * att::LOG2E;
            att::sel_unit(bh / NH, h, j, QB, KB, VB, SEL, PO0, PO1, PO2, LS, sl2, mref2, lds + RING_OFF, tid); }
    }
    SEAM(11);
    if (IN(12)) {
        for (int u = bx; u < NB * NH * NBLK; u += G) { const int bh = u % (NB * NH), i = u / (NB * NH); const int h = bh % NH; const float sl2 = __builtin_amdgcn_exp2f(-0.5f * (float)(h + 1)) * att::LOG2E;
            att::own_unit(bh / NH, h, i, QB, KB, VB, PO0, PO1, PO2, LS, QB, sl2, mref2, lds + RING_OFF, tid); }
    }
    SEAM(12);
    if (IN(13)) {
        pg8::Gemm g{QB, WO, M, DM, DM}; pg8::StaticOrder S; S.init(M, DM, G, bx);
        pg8::EpiRes E{out, out, DM};
        pg8::gemm_phase<pg8::EpiRes, pg8::StaticOrder, PG8_ALIGN, PG8_SP2>(lds + RING_OFF, g, S, E);
    }
    SEAM(13);
    if (IN(14)) rms_rows(out, ffn_norm + DM, HB, gw, NGW, lane);
    SEAM(14);
    if (IN(15)) {
        pg8::Gemm g{HB, WUP1, M, DFF, DM}; pg8::StaticOrder S; S.init(M, DFF, G, bx);
        pg8::EpiAct<2> E{HID, DFF, 0, 0, 0};
        pg8::gemm_phase<pg8::EpiAct<2>, pg8::StaticOrder, PG8_ALIGN, PG8_SP2>(lds + RING_OFF, g, S, E);
    }
    SEAM(15);
    if (IN(16)) {
        pg8::Gemm g{HID, WDN1, M, DM, DFF}; pg8::StaticOrder S; S.init(M, DM, G, bx);
        pg8::EpiRes E{out, out, DM};
        pg8::gemm_phase<pg8::EpiRes, pg8::StaticOrder, PG8_ALIGN, PG8_SP2>(lds + RING_OFF, g, S, E);
    }
#undef IN
#undef SEAM
}

extern "C" void kernel_launch(void* const* d_in, const int* in_sizes, int n_in, void* d_out, int out_size, void* d_ws, size_t ws_size, hipStream_t stream) {
    static int grid = 0;
    if (grid == 0) {
        if (n_in != 15 || in_sizes[0] != M * DM || out_size != M * DM || ws_size < WS_END) {
            fprintf(stderr, "kernel_launch: built for 15 inputs, x/out of %d floats, >= %zu bytes of workspace; got n_in %d, in0 %d, out %d, ws %zu; nothing launched\n", M * DM, (size_t)WS_END, n_in, n_in > 0 ? in_sizes[0] : -1, out_size, ws_size);
            grid = -1; return; }
        int dev = 0, cus = 0, per_cu = 0;
        if (hipGetDevice(&dev) != hipSuccess || hipDeviceGetAttribute(&cus, hipDeviceAttributeMultiprocessorCount, dev) != hipSuccess) { fprintf(stderr, "kernel_launch: device query failed\n"); grid = -1; return; }
        if (hipFuncSetAttribute((const void*)fwd, hipFuncAttributeMaxDynamicSharedMemorySize, LDS_BYTES) != hipSuccess) { fprintf(stderr, "kernel_launch: hipFuncSetAttribute failed\n"); grid = -1; return; }
        if (hipOccupancyMaxActiveBlocksPerMultiprocessor(&per_cu, (const void*)fwd, NWAVES * 64, LDS_BYTES) != hipSuccess || per_cu < 1)
            fprintf(stderr, "kernel_launch: note: occupancy query reports %d workgroups per CU\n", per_cu);
        (void)hipGetLastError();
        grid = cus;
    }
    if (grid < 0) return;
    if (hipMemsetAsync((char*)d_ws + WS_CTL, 0, CTL_ZERO_BYTES, stream) != hipSuccess) { fprintf(stderr, "kernel_launch: memset failed\n"); return; }
    Args a{};
    for (int i = 0; i < 15; ++i) a.in[i] = (const float*)d_in[i];
    a.out = (float*)d_out; a.ws = (unsigned char*)d_ws;
#if MK_PER_PHASE
    for (int p = 0; p < N_PHASES; ++p) { a.ph_lo = p; a.ph_hi = p + 1; hipLaunchKernelGGL(fwd, dim3(grid), dim3(NWAVES * 64), LDS_BYTES, stream, a); }
#else
    a.ph_lo = 0; a.ph_hi = N_PHASES;
    hipLaunchKernelGGL(fwd, dim3(grid), dim3(NWAVES * 64), LDS_BYTES, stream, a);
#endif
    const hipError_t le = hipPeekAtLastError();
    if (le != hipSuccess) fprintf(stderr, "kernel_launch: launch failed: %s\n", hipGetErrorName(le));
}
```

```cpp
#include <hip/hip_runtime.h>
#include <cstdio>
#include <cstdint>

namespace pg8 {
#define PG8_LAS __attribute__((address_space(3)))
typedef unsigned short bf16_t;
typedef short bf16x8 __attribute__((ext_vector_type(8)));
typedef float f32x4 __attribute__((ext_vector_type(4)));
typedef unsigned u32x4 __attribute__((ext_vector_type(4)));
typedef int i32x4 __attribute__((ext_vector_type(4)));
constexpr int BM = 256, BK = 64, HALF = 128, HTB = HALF * BK * 2  , STAGE_BYTES = 8 * HTB, NXCD = 8, WGM = 4;

__host__ __device__ __forceinline__ int lds_byte(int r, int c) { const int st = (r >> 4) * 2 + (c >> 5), rr = r & 15, cc = c & 31, ob = rr * 64 + cc * 2; return st * 1024 + (ob ^ (((ob >> 9) & 1) << 5)); }
__host__ __device__ __forceinline__ void stage_rc(int b, int& R, int& C) { const int st = b / 1024, sb = b % 1024, swz = sb ^ (((sb >> 9) & 1) << 5); R = (st >> 1) * 16 + swz / 64; C = (st & 1) * 32 + (swz % 64) / 2; }
__host__ __device__ __forceinline__ int perm32(int rho) { const int n = rho >> 4, i = rho & 15; return 8 * (i >> 2) + 4 * n + (i & 3); }

struct Unit { int pm, pn, idx; };
struct Gemm { const bf16_t* A; const bf16_t* Bt; int M, N, K; int a_tiled; };

struct StaticOrder {
    int nM, nN, nwg, G, c;
    __host__ __device__ void init(int M, int N, int G_, int c_) { nM = M / BM; nN = N / BM; nwg = nM * nN; G = G_; c = c_; }
    __host__ __device__ bool next(int i, Unit& u) const {
        const long L = (long)i * G + c; if (L >= nwg) return false;
        int wgid = (int)L; { const int q = nwg / NXCD, r = nwg % NXCD, xcd = wgid % NXCD, off = wgid / NXCD; wgid = (xcd < r ? xcd * (q + 1) : r * (q + 1) + (xcd - r) * q) + off; }
        const int nig = WGM * nN, gid = wgid / nig, fm = gid * WGM, gsz = (nM - fm) < WGM ? (nM - fm) : WGM;
        u.pm = fm + ((wgid % nig) % gsz); u.pn = (wgid % nig) / gsz; u.idx = i; return true;
    }
    __device__ __forceinline__ void a_ready(const Unit&) const {}
    __device__ __forceinline__ void done(const Unit&) const {}
    __device__ __forceinline__ void after_epi(const Unit&) const {}
};

__device__ __forceinline__ unsigned cvt_pk_bf16(float lo, float hi) { unsigned r; asm volatile("v_cvt_pk_bf16_f32 %0, %1, %2" : "=v"(r) : "v"(lo), "v"(hi)); return r; }
typedef float f32x2 __attribute__((ext_vector_type(2)));
__device__ __forceinline__ f32x2 gelu_pk(f32x2 v) {
    const f32x2 av = __builtin_elementwise_abs(v), d = av * 0.2316418882f + 1.0f;
    f32x2 t; t.x = __builtin_amdgcn_rcpf(d.x); t.y = __builtin_amdgcn_rcpf(d.y);
    f32x2 q = t * 0.5307027145f + (-0.7265760135f); q = q * t + 0.7107068705f; q = q * t + (-0.142248368f); q = q * t + 0.127414796f; q = q * t;
    const f32x2 s = (v * v) * (-0.72134752044f);
    f32x2 e; e.x = __builtin_amdgcn_exp2f(s.x); e.y = __builtin_amdgcn_exp2f(s.y);
    const f32x2 m = v * (q * e), r = v - m;
    f32x2 o; o.x = v.x < 0.f ? m.x : r.x; o.y = v.y < 0.f ? m.y : r.y; return o;
}

template <class Epi, class Sched, bool ALIGN_EPI = false, bool SP2 = false>
__device__ __forceinline__ void gemm_phase(PG8_LAS unsigned char* lds, const Gemm g, const Sched& S, const Epi& E) {
    int tid_ = threadIdx.x; asm volatile("" : "+v"(tid_));
    const int tid = tid_, wid = __builtin_amdgcn_readfirstlane(tid >> 6), lane = tid & 63, wr = wid >> 2, wc = wid & 3, fr = lane & 15, fq = lane >> 4;
    const int K = g.K, nt = K / BK;
    const int lda = g.a_tiled ? BM : K;
    unsigned voffA[2], voffB[2];
#pragma unroll
    for (int i = 0; i < 2; ++i) { int R, C; stage_rc(tid * 16 + i * 8192, R, C); const int Rb = Epi::PERM ? (64 * (R >> 5) + perm32(R & 31)) : R;
        voffA[i] = (unsigned)(R * lda + C) * 2u; voffB[i] = (unsigned)(Rb * K + C) * 2u; }
    const size_t kstep = (size_t)(BK * 2);
    const size_t hstepA = (size_t)HALF * lda * 2;
    const size_t hstepB = Epi::PERM ? (size_t)32 * K * 2 : hstepA;
    const size_t tstep = (size_t)BM * K * 2;
    const size_t tstepA = g.a_tiled == 2 ? (size_t)BM * K * 4 : tstep;
    const unsigned ldsw = (unsigned)wid * 1024u;
    const int aoff = lds_byte(wr * 64 + fr, fq * 8), boff = lds_byte(wc * 32 + fr, fq * 8);
#define PG8_SA(b, h) (((b) * 2 + (h)) * HTB)
#define PG8_SB(b, h) ((4 + (b) * 2 + (h)) * HTB)
#define PG8_STAGE(bufoff, gbase, voff) do { _Pragma("unroll") for (int _i = 0; _i < 2; ++_i) \
        __builtin_amdgcn_global_load_lds((const unsigned*)((const char*)(gbase) + (voff)[_i]), (PG8_LAS unsigned*)(lds + (bufoff) + ldsw + _i * 8192), 16, 0, 0); } while (0)
#define PG8_LDA(dst, b, h) do { _Pragma("unroll") for (int m = 0; m < 4; ++m) _Pragma("unroll") for (int k = 0; k < 2; ++k) dst[m][k] = *(const PG8_LAS bf16x8*)(lds + PG8_SA(b, h) + aoff + m * 2048 + k * 1024); } while (0)
#define PG8_LDB(dst, b, h) do { _Pragma("unroll") for (int n = 0; n < 2; ++n) _Pragma("unroll") for (int k = 0; k < 2; ++k) dst[n][k] = *(const PG8_LAS bf16x8*)(lds + PG8_SB(b, h) + boff + n * 2048 + k * 1024); } while (0)
#define PG8_MMA(ai, bj, At, Bt) do { __builtin_amdgcn_s_setprio(1); _Pragma("unroll") for (int m = 0; m < 4; ++m) _Pragma("unroll") for (int n = 0; n < 2; ++n) _Pragma("unroll") for (int k = 0; k < 2; ++k) { \
        if constexpr (Epi::I8) acc[ai][bj][m][n] = __builtin_bit_cast(f32x4, __builtin_amdgcn_mfma_i32_16x16x64_i8(__builtin_bit_cast(i32x4, Bt[n][k]), __builtin_bit_cast(i32x4, At[m][k]), __builtin_bit_cast(i32x4, acc[ai][bj][m][n]), 0, 0, 0)); \
        else acc[ai][bj][m][n] = __builtin_amdgcn_mfma_f32_16x16x32_bf16(Bt[n][k], At[m][k], acc[ai][bj][m][n], 0, 0, 0); } __builtin_amdgcn_s_setprio(0); } while (0)
#define PG8_WAIT_V(n) asm volatile("s_waitcnt vmcnt(" #n ")" ::: "memory")
#define PG8_WAIT_L(n) asm volatile("s_waitcnt lgkmcnt(" #n ")" ::: "memory")
#define PG8_BAR __builtin_amdgcn_s_barrier()
#define PG8_SCHED __builtin_amdgcn_sched_barrier(0)
    Unit cur, nxt; int ui = 0;
    if (!S.next(0, cur)) return;
    f32x4 acc[2][2][4][2];
#pragma unroll
    for (int a = 0; a < 2; ++a)
#pragma unroll
        for (int b = 0; b < 2; ++b)
#pragma unroll
            for (int m = 0; m < 4; ++m)
#pragma unroll
                for (int n = 0; n < 2; ++n) acc[a][b][m][n] = (f32x4){0.f, 0.f, 0.f, 0.f};
    bf16x8 At[4][2], B0[2][2], B1[2][2];
    const char* cA = (const char*)g.A + (size_t)cur.pm * tstepA; const char* cB = (const char*)g.Bt + (size_t)cur.pn * tstep;
    S.a_ready(cur);
    if constexpr (SP2) {
        PG8_STAGE(PG8_SB(0, 0), cB, voffB); PG8_STAGE(PG8_SB(0, 1), cB + hstepB, voffB); PG8_STAGE(PG8_SA(0, 0), cA, voffA); PG8_STAGE(PG8_SA(0, 1), cA + hstepA, voffA);
        if (wr == 1) PG8_BAR;
        PG8_WAIT_V(2); PG8_BAR;
        PG8_STAGE(PG8_SB(1, 0), cB + kstep, voffB); PG8_STAGE(PG8_SA(1, 0), cA + kstep, voffA); PG8_STAGE(PG8_SB(1, 1), cB + hstepB + kstep, voffB);
        PG8_WAIT_V(6); PG8_BAR;
    } else {
        PG8_STAGE(PG8_SB(0, 0), cB, voffB); PG8_STAGE(PG8_SA(0, 0), cA, voffA); PG8_STAGE(PG8_SB(0, 1), cB + hstepB, voffB); PG8_STAGE(PG8_SA(0, 1), cA + hstepA, voffA);
        if (wr == 1) PG8_BAR;
        PG8_WAIT_V(4); PG8_BAR;
        PG8_STAGE(PG8_SB(1, 0), cB + kstep, voffB); PG8_STAGE(PG8_SA(1, 0), cA + kstep, voffA); PG8_STAGE(PG8_SB(1, 1), cB + hstepB + kstep, voffB);
        PG8_WAIT_V(6); PG8_BAR;
    }
    for (;;) {
        const bool has_next = S.next(ui + 1, nxt);
        const char* nA = has_next ? (const char*)g.A + (size_t)nxt.pm * tstepA : cA; const char* nB = has_next ? (const char*)g.Bt + (size_t)nxt.pn * tstep : cB;
        for (int t = 0; t < nt; t += 2) {
            const bool last = (t == nt - 2);
            const size_t ka = g.a_tiled == 2 ? ((size_t)(t >> 1) << 17) : g.a_tiled ? (((size_t)(t >> 2) << 17) + (size_t)((t & 2) << 7)) : (size_t)t * kstep, ka2 = g.a_tiled == 2 ? ((size_t)((t + 2) >> 1) << 17) : g.a_tiled ? (((size_t)((t + 2) >> 2) << 17) + (size_t)(((t + 2) & 2) << 7)) : (size_t)(t + 2) * kstep;
            const char* a1 = cA + ka + kstep;
            const char* a2 = last ? nA : cA + ka2; const char* b2 = last ? nB : cB + (size_t)(t + 2) * kstep;
            const char* a3 = a2 + kstep; const char* b3 = b2 + kstep;
            if (last && has_next) S.a_ready(nxt);
            if constexpr (SP2) {
            PG8_LDB(B0, 0, 0); PG8_LDB(B1, 0, 1); PG8_SCHED; PG8_LDA(At, 0, 0); PG8_STAGE(PG8_SA(1, 1), a1 + hstepA, voffA);
            PG8_WAIT_V(8); PG8_WAIT_L(0); PG8_BAR; PG8_MMA(0, 0, At, B0); PG8_MMA(0, 1, At, B1); PG8_BAR; PG8_SCHED;
            PG8_LDA(At, 0, 1); PG8_STAGE(PG8_SB(0, 0), b2, voffB); PG8_STAGE(PG8_SB(0, 1), b2 + hstepB, voffB); PG8_STAGE(PG8_SA(0, 0), a2, voffA);
            PG8_WAIT_V(8); PG8_WAIT_L(0); PG8_BAR; PG8_MMA(1, 0, At, B0); PG8_MMA(1, 1, At, B1); PG8_BAR; PG8_SCHED;
            PG8_LDB(B0, 1, 0); PG8_LDB(B1, 1, 1); PG8_SCHED; PG8_LDA(At, 1, 0); PG8_STAGE(PG8_SA(0, 1), a2 + hstepA, voffA);
            PG8_WAIT_V(8); PG8_WAIT_L(0); PG8_BAR; PG8_MMA(0, 0, At, B0); PG8_MMA(0, 1, At, B1); PG8_BAR; PG8_SCHED;
            PG8_LDA(At, 1, 1); PG8_STAGE(PG8_SB(1, 0), b3, voffB); PG8_STAGE(PG8_SB(1, 1), b3 + hstepB, voffB); PG8_STAGE(PG8_SA(1, 0), a3, voffA);
            PG8_WAIT_V(8); PG8_WAIT_L(0); PG8_BAR; PG8_MMA(1, 0, At, B0); PG8_MMA(1, 1, At, B1); PG8_BAR; PG8_SCHED;
            } else {
            PG8_LDB(B0, 0, 0); PG8_SCHED; PG8_LDA(At, 0, 0); PG8_STAGE(PG8_SA(1, 1), a1 + hstepA, voffA);
            PG8_WAIT_L(8); PG8_BAR; PG8_WAIT_L(0); PG8_MMA(0, 0, At, B0); PG8_BAR; PG8_SCHED;
            PG8_LDB(B1, 0, 1); PG8_STAGE(PG8_SB(0, 0), b2, voffB);
            PG8_BAR; PG8_WAIT_L(0); PG8_MMA(0, 1, At, B1); PG8_BAR;
            PG8_LDA(At, 0, 1); PG8_STAGE(PG8_SA(0, 0), a2, voffA);
            PG8_BAR; PG8_WAIT_L(0); PG8_MMA(1, 0, At, B0); PG8_BAR; PG8_SCHED;
            PG8_STAGE(PG8_SB(0, 1), b2 + hstepB, voffB);
            PG8_WAIT_V(6); PG8_BAR; PG8_MMA(1, 1, At, B1); PG8_BAR;
            PG8_LDB(B0, 1, 0); PG8_SCHED; PG8_LDA(At, 1, 0); PG8_STAGE(PG8_SA(0, 1), a2 + hstepA, voffA);
            PG8_WAIT_L(8); PG8_BAR; PG8_WAIT_L(0); PG8_MMA(0, 0, At, B0); PG8_BAR; PG8_SCHED;
            PG8_LDB(B1, 1, 1); PG8_STAGE(PG8_SB(1, 0), b3, voffB);
            PG8_BAR; PG8_WAIT_L(0); PG8_MMA(0, 1, At, B1); PG8_BAR;
            PG8_LDA(At, 1, 1); PG8_STAGE(PG8_SA(1, 0), a3, voffA);
            PG8_BAR; PG8_WAIT_L(0); PG8_MMA(1, 0, At, B0); PG8_BAR; PG8_SCHED;
            PG8_STAGE(PG8_SB(1, 1), b3 + hstepB, voffB);
            PG8_WAIT_V(6); PG8_BAR; PG8_MMA(1, 1, At, B1); PG8_BAR;
            }
        }
        if constexpr (ALIGN_EPI) { if (wr == 0) PG8_BAR; }
        if constexpr (!Epi::AFTER_DRAIN) { E(acc, cur, wr, wc, fr, fq); S.done(cur); if (has_next) S.after_epi(nxt); }
        if (!has_next) break;
#pragma unroll
        for (int a = 0; a < 2; ++a)
#pragma unroll
            for (int b = 0; b < 2; ++b)
#pragma unroll
                for (int m = 0; m < 4; ++m)
#pragma unroll
                    for (int n = 0; n < 2; ++n) acc[a][b][m][n] = (f32x4){0.f, 0.f, 0.f, 0.f};
        cur = nxt; cA = nA; cB = nB; ++ui;
        if constexpr (ALIGN_EPI) { if (wr == 1) PG8_BAR; }
    }
    PG8_WAIT_V(0);
    if constexpr (!ALIGN_EPI) { if (wr == 0) PG8_BAR; }
    PG8_BAR;
    if constexpr (Epi::AFTER_DRAIN) { E.fused(acc, cur, wr, wc, fr, fq, lds, wid, lane); S.done(cur); }
#undef PG8_SA
#undef PG8_SB
#undef PG8_STAGE
#undef PG8_LDA
#undef PG8_LDB
#undef PG8_MMA
#undef PG8_WAIT_V
#undef PG8_WAIT_L
#undef PG8_BAR
#undef PG8_SCHED
}
}

namespace pg8 {
__device__ __forceinline__ float gelu_tanh(float x) {
    const float y = x * (0.7978845608028654f + 0.035677408136300125f * x * x);
    const float e = __builtin_amdgcn_exp2f(y * (-2.0f * 1.4426950408889634f));
    return x * __builtin_amdgcn_rcpf(1.0f + e);
}
constexpr int RSS_PER_ROW = 32;
struct NormOrder : StaticOrder {
    const float* rss; PG8_LAS float* tab; float inv_n, eps;
    __device__ __forceinline__ void a_ready(const Unit& u) const { if (u.idx == 0) table(u); }
    __device__ __forceinline__ void after_epi(const Unit& u) const { table(u); }
    __device__ __forceinline__ void table(const Unit& u) const {
        int t_ = threadIdx.x; asm volatile("" : "+v"(t_));
        const int lane = t_ & 63, wid = __builtin_amdgcn_readfirstlane(t_ >> 6), row = wid * 32 + (lane & 31), half = lane >> 5;
        const f32x4* p = (const f32x4*)(rss + (size_t)(u.pm * BM + row) * RSS_PER_ROW + half * 16);
        float s;
        { const f32x4 a = p[0], b = p[1]; s = ((a[0] + a[1]) + (a[2] + a[3])) + ((b[0] + b[1]) + (b[2] + b[3])); }
        asm volatile("" : "+v"(s));
        { const f32x4 c = p[2], d = p[3]; s += ((c[0] + c[1]) + (c[2] + c[3])) + ((d[0] + d[1]) + (d[2] + d[3])); }
        s += __shfl_xor(s, 32);
        if (half == 0) tab[(u.idx & 1) * BM + row] = 1.0f / sqrtf(s * inv_n + eps);
    }
};
struct ScaleOrder : StaticOrder {
    const float* rows; PG8_LAS float* tab;
    __device__ __forceinline__ void a_ready(const Unit& u) const { if (u.idx == 0) table(u); }
    __device__ __forceinline__ void after_epi(const Unit& u) const { table(u); }
    __device__ __forceinline__ void table(const Unit& u) const {
        int t_ = threadIdx.x; asm volatile("" : "+v"(t_));
        if (t_ < BM) tab[(u.idx & 1) * BM + t_] = rows[(size_t)u.pm * BM + t_];
    }
};
__device__ __forceinline__ unsigned dpp_x1(unsigned v) { return (unsigned)__builtin_amdgcn_update_dpp(0, (int)v, 0xB1, 0xF, 0xF, true); }
__device__ __forceinline__ void pair_lines(u32x4& w0, u32x4& w1, bool odd) {
#pragma unroll
    for (int c = 0; c < 4; ++c) { const unsigned a = w0[c], b = w1[c], na = dpp_x1(a), nb = dpp_x1(b); w0[c] = odd ? nb : a; w1[c] = odd ? b : na; }
}
template <int ACT, int PROBE = 0, bool TILED = false, bool I8_ = false> struct EpiActR {
    static constexpr bool PERM = true, AFTER_DRAIN = false, I8 = I8_;
    bf16_t* O; int ldc; int split_cols; size_t split_stride; const PG8_LAS float* tab; int act_tile0; const float* colmax;
    __device__ __forceinline__ void operator()(const f32x4 (&acc)[2][2][4][2], const Unit& u, int wr, int wc, int fr, int fq) const {
        const int row0 = u.pm * BM + wr * 64 + fr; int colt = u.pn * BM; bf16_t* base = O;
        if (split_cols) { const int t = colt / split_cols; base += (size_t)t * split_stride; colt -= t * split_cols; }
        const bool odd = (fr & 1) != 0;
        const int colx = colt + wc * 64 + 8 * fq + (odd ? 32 : 0);
        const int ldo = TILED ? BM : ldc;
        const unsigned offA = TILED ? (unsigned)(((wr * 64 + fr) & ~1) * BM + wc * 64 + 8 * fq + (odd ? 32 : 0)) * 2u : (unsigned)((row0 & ~1) * ldc + colx) * 2u, offB = offA + (unsigned)ldo * 2u;
        if (TILED) base += (size_t)(u.pm * (ldc / BM) + u.pn) * (BM * BM);
        const PG8_LAS float* tb = tab + (u.idx & 1) * BM + wr * 64 + fr;
        if (PROBE == 2) {
#pragma unroll
            for (int ai = 0; ai < 2; ++ai)
#pragma unroll
                for (int m = 0; m < 4; ++m)
#pragma unroll
                    for (int bj = 0; bj < 2; ++bj) asm volatile("" :: "v"(acc[ai][bj][m][0]), "v"(acc[ai][bj][m][1]));
            return; }
        f32x4 cs[2][2];
        if constexpr (I8) {
#pragma unroll
            for (int bj = 0; bj < 2; ++bj)
#pragma unroll
                for (int n = 0; n < 2; ++n) cs[bj][n] = *(const f32x4*)(colmax + u.pn * BM + wc * 64 + 32 * bj + 8 * fq + 4 * n) * (1.0f / 127.0f); }
#pragma unroll
        for (int ai = 0; ai < 2; ++ai)
#pragma unroll
            for (int m = 0; m < 4; ++m) { const float r = tb[ai * HALF + m * 16];
                u32x4 w[2];
#pragma unroll
                for (int bj = 0; bj < 2; ++bj) { f32x4 v0, v1;
                    if constexpr (I8) { const i32x4 i0 = __builtin_bit_cast(i32x4, acc[ai][bj][m][0]), i1 = __builtin_bit_cast(i32x4, acc[ai][bj][m][1]);
                        v0 = (f32x4){(float)i0[0], (float)i0[1], (float)i0[2], (float)i0[3]} * cs[bj][0] * r; v1 = (f32x4){(float)i1[0], (float)i1[1], (float)i1[2], (float)i1[3]} * cs[bj][1] * r; }
                    else { v0 = acc[ai][bj][m][0] * r; v1 = acc[ai][bj][m][1] * r; }
                    if (ACT == 1) { if (u.pn >= act_tile0) {
#pragma unroll
                        for (int e = 0; e < 4; ++e) { v0[e] = gelu_tanh(v0[e]); v1[e] = gelu_tanh(v1[e]); } } }
                    if (ACT == 2) {
#pragma unroll
                        for (int e = 0; e < 4; ++e) { const float a = fmaxf(v0[e], 0.f), b = fmaxf(v1[e], 0.f); v0[e] = a * a; v1[e] = b * b; } }
                    w[bj].x = cvt_pk_bf16(v0[0], v0[1]); w[bj].y = cvt_pk_bf16(v0[2], v0[3]); w[bj].z = cvt_pk_bf16(v1[0], v1[1]); w[bj].w = cvt_pk_bf16(v1[2], v1[3]); }
                pair_lines(w[0], w[1], odd);
                if (PROBE == 1) asm volatile("" :: "v"(w[0]), "v"(w[1]));
                else { char* pr = (char*)base + (size_t)(ai * HALF + m * 16) * ldo * 2; *(u32x4*)(pr + offA) = w[0]; *(u32x4*)(pr + offB) = w[1]; } }
    }
};
template <bool I8_ = false> struct EpiQKVT {
    static constexpr bool PERM = true, AFTER_DRAIN = false, I8 = I8_;
    bf16_t* O; int ldc; size_t split_stride; const PG8_LAS float* tab; PG8_LAS float* xch; const float* q_gain; const float* k_gain; float* kmp; float eps; int nh, nblk; const float* colmax;
    __device__ __forceinline__ void operator()(f32x4 (&v)[2][2][4][2], const Unit& u, int wr, int wc, int fr, int fq) const {
        const int t = u.pn >> 3, colt = (u.pn & 7) * BM;
        const int row0 = u.pm * BM + wr * 64 + fr;
        const int hl = wc >> 1, ch = (wc & 1) * 64 + 8 * fq;
        const bool odd = (fr & 1) != 0;
        const int colx = colt + wc * 64 + 8 * fq + (odd ? 32 : 0);
        const unsigned offA = (unsigned)((row0 & ~1) * ldc + colx) * 2u, offB = offA + (unsigned)ldc * 2u;
        bf16_t* base = O + (size_t)t * split_stride;
        const PG8_LAS float* tb = tab + (u.idx & 1) * BM + wr * 64 + fr;
        f32x4 csq[2][2];
        if constexpr (I8) {
#pragma unroll
            for (int bj = 0; bj < 2; ++bj)
#pragma unroll
                for (int n = 0; n < 2; ++n) csq[bj][n] = *(const f32x4*)(colmax + u.pn * BM + wc * 64 + 32 * bj + 8 * fq + 4 * n) * (1.0f / 127.0f); }
#pragma unroll
        for (int ai = 0; ai < 2; ++ai)
#pragma unroll
            for (int m = 0; m < 4; ++m) { const float r = tb[ai * HALF + m * 16];
#pragma unroll
                for (int bj = 0; bj < 2; ++bj) {
                    if constexpr (I8) { const i32x4 i0 = __builtin_bit_cast(i32x4, v[ai][bj][m][0]), i1 = __builtin_bit_cast(i32x4, v[ai][bj][m][1]);
                        v[ai][bj][m][0] = (f32x4){(float)i0[0], (float)i0[1], (float)i0[2], (float)i0[3]} * csq[bj][0] * r; v[ai][bj][m][1] = (f32x4){(float)i1[0], (float)i1[1], (float)i1[2], (float)i1[3]} * csq[bj][1] * r; }
                    else { v[ai][bj][m][0] = v[ai][bj][m][0] * r; v[ai][bj][m][1] = v[ai][bj][m][1] * r; } } }
        if (t < 2) {
#pragma unroll
            for (int ai = 0; ai < 2; ++ai)
#pragma unroll
                for (int m = 0; m < 4; ++m) { float ss = 0.f;
#pragma unroll
                    for (int bj = 0; bj < 2; ++bj) { const f32x4 x0 = v[ai][bj][m][0], x1 = v[ai][bj][m][1];
                        ss += ((x0[0] * x0[0] + x0[1] * x0[1]) + (x0[2] * x0[2] + x0[3] * x0[3])) + ((x1[0] * x1[0] + x1[1] * x1[1]) + (x1[2] * x1[2] + x1[3] * x1[3])); }
                    ss += __shfl_xor(ss, 16); ss += __shfl_xor(ss, 32);
                    if (fq == 0) xch[(hl * BM + ai * HALF + wr * 64 + m * 16 + fr) * 2 + (wc & 1)] = ss; }
            asm volatile("s_waitcnt lgkmcnt(0)" ::: "memory"); __builtin_amdgcn_s_barrier(); asm volatile("" ::: "memory");
            const float* gain = (t == 0) ? q_gain : k_gain;
            f32x4 g[2][2];
#pragma unroll
            for (int bj = 0; bj < 2; ++bj)
#pragma unroll
                for (int n = 0; n < 2; ++n) g[bj][n] = *(const f32x4*)(gain + ch + 32 * bj + 4 * n);
#pragma unroll
            for (int ai = 0; ai < 2; ++ai)
#pragma unroll
                for (int m = 0; m < 4; ++m) { const PG8_LAS float* sp = xch + (hl * BM + ai * HALF + wr * 64 + m * 16 + fr) * 2;
                    const float rh = 1.0f / sqrtf((sp[0] + sp[1]) * (1.0f / 128.0f) + eps);
#pragma unroll
                    for (int bj = 0; bj < 2; ++bj) { v[ai][bj][m][0] = v[ai][bj][m][0] * rh * g[bj][0]; v[ai][bj][m][1] = v[ai][bj][m][1] * rh * g[bj][1]; } }
            if (t == 1) {
#pragma unroll
                for (int bj = 0; bj < 2; ++bj) { f32x4 s0 = {0.f, 0.f, 0.f, 0.f}, s1 = {0.f, 0.f, 0.f, 0.f};
#pragma unroll
                    for (int ai = 0; ai < 2; ++ai)
#pragma unroll
                        for (int m = 0; m < 4; ++m) { s0 = s0 + v[ai][bj][m][0]; s1 = s1 + v[ai][bj][m][1]; }
#pragma unroll
                    for (int e = 0; e < 4; ++e) {
#pragma unroll
                        for (int o = 1; o < 16; o <<= 1) { s0[e] += __shfl_xor(s0[e], o); s1[e] += __shfl_xor(s1[e], o); } }
                    if (fr == 0) { const int b = u.pm / nblk, blk = u.pm % nblk, h = (u.pn & 7) * 2 + hl;
                        float* dst = kmp + ((((size_t)(b * nh + h) * nblk + blk) * 2 + wr) * 128 + ch + 32 * bj);
                        *(f32x4*)dst = s0 * (1.0f / 256.0f); *(f32x4*)(dst + 4) = s1 * (1.0f / 256.0f); } }
            }
        }
#pragma unroll
        for (int ai = 0; ai < 2; ++ai)
#pragma unroll
            for (int m = 0; m < 4; ++m) {
                u32x4 w[2];
#pragma unroll
                for (int bj = 0; bj < 2; ++bj) { const f32x4 v0 = v[ai][bj][m][0], v1 = v[ai][bj][m][1];
                    w[bj].x = cvt_pk_bf16(v0[0], v0[1]); w[bj].y = cvt_pk_bf16(v0[2], v0[3]); w[bj].z = cvt_pk_bf16(v1[0], v1[1]); w[bj].w = cvt_pk_bf16(v1[2], v1[3]); }
                pair_lines(w[0], w[1], odd);
                char* pr = (char*)base + (size_t)(ai * HALF + m * 16) * ldc * 2; *(u32x4*)(pr + offA) = w[0]; *(u32x4*)(pr + offB) = w[1]; }
    }
};
typedef EpiQKVT<false> EpiQKV;
template <bool FINAL, bool I8_ = false, bool OFFS = false> struct EpiResB {
    static constexpr bool PERM = true, AFTER_DRAIN = false, I8 = I8_;
    bf16_t* xb; int ldx; float* out; int ldo; float* rss; const PG8_LAS float* tab; const float* colmax; const int* colsum;
    __device__ __forceinline__ void operator()(const f32x4 (&acc)[2][2][4][2], const Unit& u, int wr, int wc, int fr, int fq) const {
        const int row0 = u.pm * BM + wr * 64 + fr, col0 = u.pn * BM + wc * 64 + 8 * fq;
        const bool odd = (fr & 1) != 0;
        const int colx = col0 + (odd ? 32 : 0);
        const unsigned offA = (unsigned)((row0 & ~1) * ldx + colx) * 2u, offB = offA + (unsigned)ldx * 2u;
        f32x4 cs[2][2], oc[2][2];
        if constexpr (I8) {
#pragma unroll
            for (int bj = 0; bj < 2; ++bj)
#pragma unroll
                for (int n = 0; n < 2; ++n) { cs[bj][n] = *(const f32x4*)(colmax + col0 + 32 * bj + 4 * n) * (1.0f / 127.0f);
                    if constexpr (OFFS) { const i32x4 s = *(const i32x4*)(colsum + col0 + 32 * bj + 4 * n);
                        oc[bj][n] = (f32x4){(float)s[0], (float)s[1], (float)s[2], (float)s[3]} * 128.0f * cs[bj][n]; } } }
        constexpr int NH_ = OFFS ? 1 : 2;
        u32x4 w[NH_][4][2];
        if constexpr (!OFFS) {
#pragma unroll
            for (int ai = 0; ai < 2; ++ai)
#pragma unroll
                for (int m = 0; m < 4; ++m) { const char* pr = (const char*)xb + (size_t)(ai * HALF + m * 16) * ldx * 2;
                    w[ai][m][0] = *(const u32x4*)(pr + offA); w[ai][m][1] = *(const u32x4*)(pr + offB); } }
#pragma unroll
        for (int ai = 0; ai < 2; ++ai) {
            const int wi = OFFS ? 0 : ai;
            if constexpr (OFFS) {
#pragma unroll
                for (int m = 0; m < 4; ++m) { const char* pr = (const char*)xb + (size_t)(ai * HALF + m * 16) * ldx * 2;
                    w[0][m][0] = *(const u32x4*)(pr + offA); w[0][m][1] = *(const u32x4*)(pr + offB); } }
#pragma unroll
            for (int m = 0; m < 4; ++m) { const int row = row0 + ai * HALF + m * 16;
                const float rsc = I8 ? tab[(u.idx & 1) * BM + wr * 64 + fr + ai * HALF + m * 16] : 1.0f;
                pair_lines(w[wi][m][0], w[wi][m][1], odd);
                float ss = 0.f; u32x4 o[2];
#pragma unroll
                for (int bj = 0; bj < 2; ++bj) {
                    const u32x4 wv = w[wi][m][bj];
                    f32x4 x0, x1;
                    x0[0] = __uint_as_float(wv.x << 16); x0[1] = __uint_as_float(wv.x & 0xffff0000u); x0[2] = __uint_as_float(wv.y << 16); x0[3] = __uint_as_float(wv.y & 0xffff0000u);
                    x1[0] = __uint_as_float(wv.z << 16); x1[1] = __uint_as_float(wv.z & 0xffff0000u); x1[2] = __uint_as_float(wv.w << 16); x1[3] = __uint_as_float(wv.w & 0xffff0000u);
                    if constexpr (I8) { const i32x4 i0 = __builtin_bit_cast(i32x4, acc[ai][bj][m][0]), i1 = __builtin_bit_cast(i32x4, acc[ai][bj][m][1]);
                        f32x4 a0 = (f32x4){(float)i0[0], (float)i0[1], (float)i0[2], (float)i0[3]} * cs[bj][0], a1 = (f32x4){(float)i1[0], (float)i1[1], (float)i1[2], (float)i1[3]} * cs[bj][1];
                        if constexpr (OFFS) { a0 = a0 + oc[bj][0]; a1 = a1 + oc[bj][1]; }
                        x0 = x0 + a0 * rsc; x1 = x1 + a1 * rsc; }
                    else { x0 = x0 + acc[ai][bj][m][0]; x1 = x1 + acc[ai][bj][m][1]; }
                    if (FINAL) { float* op = out + (size_t)row * ldo + col0 + 32 * bj; *(f32x4*)op = x0; *(f32x4*)(op + 4) = x1; }
                    else {
                        ss += ((x0[0] * x0[0] + x0[1] * x0[1]) + (x0[2] * x0[2] + x0[3] * x0[3])) + ((x1[0] * x1[0] + x1[1] * x1[1]) + (x1[2] * x1[2] + x1[3] * x1[3]));
                        o[bj].x = cvt_pk_bf16(x0[0], x0[1]); o[bj].y = cvt_pk_bf16(x0[2], x0[3]); o[bj].z = cvt_pk_bf16(x1[0], x1[1]); o[bj].w = cvt_pk_bf16(x1[2], x1[3]); } }
                if (!FINAL) {
                    pair_lines(o[0], o[1], odd);
                    char* pr = (char*)xb + (size_t)(ai * HALF + m * 16) * ldx * 2; *(u32x4*)(pr + offA) = o[0]; *(u32x4*)(pr + offB) = o[1];
                    ss += __shfl_xor(ss, 16); ss += __shfl_xor(ss, 32); if (fq == 0) rss[(size_t)row * RSS_PER_ROW + u.pn * 4 + wc] = ss; }
            }
        }
    }
};
}

#ifndef PG8_SP2
#define PG8_SP2 true
#endif
#ifndef PG8_ALIGN
#define PG8_ALIGN true
#endif
constexpr int NWAVES = 8;
constexpr int NB = 2, SEQ = 16384, DM = 2048, M = NB * SEQ, DFF = 8192, NMIX = 5120, NQKV = 6144, NH = 16, HD = 128, BLK = 256, NBLK = SEQ / BLK;
constexpr int CW = 1024, SGW = 1024, SGG = 8, SGD = 128, SGC = 128;
constexpr float EPS = 1e-6f;
constexpr int N_PHASES = 17;
constexpr size_t MiB = 1u << 20;
constexpr size_t WS_CTL = 0, CTL_ZERO_BYTES = 256 * 1024;
constexpr size_t WS_CMAX_DN = 184 * 1024;
constexpr size_t WS_CSUM_DN = 200 * 1024;
constexpr size_t WS_HROWS = 13 * MiB + 768 * 1024;
constexpr size_t WS_CMAX_QKV = 160 * 1024;
constexpr size_t WS_CMAX_O = 152 * 1024;
constexpr size_t WS_CMAX_IN = 128 * 1024;
constexpr size_t WS_CMAX = 64 * 1024;
constexpr size_t WS_ROWS = 13 * MiB + 512 * 1024;
constexpr size_t WS_KMP = 1 * MiB;
constexpr size_t WS_SEL = 3 * MiB;
constexpr size_t WS_LS = 5 * MiB;
constexpr size_t WS_RSS = 14 * MiB;
constexpr size_t WS_WSB = 13 * MiB;
constexpr size_t WS_WIN = 18 * MiB, WS_WOUT = 38 * MiB, WS_WUP0 = 46 * MiB, WS_WDN0 = 78 * MiB, WS_WQKV = 110 * MiB, WS_WO = 134 * MiB, WS_WUP1 = 142 * MiB, WS_WDN1 = 174 * MiB;
constexpr size_t WS_HB = 206 * MiB;
constexpr size_t WS_BIG = 334 * MiB;
constexpr size_t WS_Z = WS_BIG, WS_CAT = WS_BIG + 320 * MiB, WS_HID = WS_BIG, WS_Q = WS_BIG, WS_K = WS_BIG + 128 * MiB, WS_V = WS_BIG + 256 * MiB;
constexpr size_t WS_PO0 = WS_BIG + 384 * MiB, WS_PO1 = WS_BIG + 512 * MiB, WS_PO2 = WS_HB;
constexpr size_t WS_XQ = WS_PO1;
constexpr size_t WS_END = WS_PO1 + 128 * MiB;
static_assert(WS_END <= 1024 * MiB, "workspace map");
constexpr int CW_QUEUE = 6144;
constexpr int CW_SELQ = 512;
constexpr int CW_BAR = 1024;
constexpr int RING_OFF = 0, RING_BYTES = 131072, LDSCTL_OFF = 149504, MISC_OFF = LDSCTL_OFF + 320, RINV_OFF = 151552, XCH_OFF = 153600, LDS_BYTES = 161792;

#define GAS __attribute__((address_space(1)))
#define LAS __attribute__((address_space(3)))
typedef unsigned short bf16;
typedef unsigned v4u __attribute__((ext_vector_type(4)));
typedef float f32x4 __attribute__((ext_vector_type(4)));
typedef short bf16x8 __attribute__((ext_vector_type(8)));
typedef GAS unsigned gu32;
typedef GAS unsigned long long gu64;
#define RLX_AGENT __ATOMIC_RELAXED, __HIP_MEMORY_SCOPE_AGENT
#define LDS_WAIT() asm volatile("s_waitcnt lgkmcnt(0)" ::: "memory")
#define VM_WAIT() asm volatile("s_waitcnt vmcnt(0)" ::: "memory")
__device__ __forceinline__ unsigned long long rt() { return __builtin_amdgcn_s_memrealtime(); }
__device__ __forceinline__ unsigned f2bf(float f) { unsigned u = __builtin_bit_cast(unsigned, f); return (u + 0x7fffu + ((u >> 16) & 1u)) >> 16; }
__device__ __forceinline__ unsigned pk2(float lo, float hi) { return f2bf(lo) | (f2bf(hi) << 16); }

#define XB_TMO      128
#define XB_XCNT(j)  (256  + 64 * (j))
#define XB_XSUB(j)  (1280 + 64 * (j))
#define XB_XGEN(j)  (2304 + 64 * (j))
#define XB_TOP      3328
#define XB_TOPGEN   3392
#define XCD_BAR_WORDS 3456
#define XB_SPIN_CAP (1u << 18)

__device__ __forceinline__ unsigned xb_ld(unsigned* p)              { return __hip_atomic_load(p, __ATOMIC_RELAXED, __HIP_MEMORY_SCOPE_AGENT); }
__device__ __forceinline__ unsigned xb_add(unsigned* p, unsigned v) { return __hip_atomic_fetch_add(p, v, __ATOMIC_RELAXED, __HIP_MEMORY_SCOPE_AGENT); }
__device__ __forceinline__ unsigned xb_xcc_id() { return (unsigned)__builtin_amdgcn_s_getreg((3 << 11) | 20) & 0xFu; }
#define XB_SPIN(cond, bar) do { unsigned _sp = 0; while (cond) { __builtin_amdgcn_s_sleep(1); \
    if ((++_sp & 255u) == 0u) { if (xb_ld(&(bar)[XB_TMO])) break; if (_sp > XB_SPIN_CAP) { atomicAdd(&(bar)[XB_TMO], 1u); break; } } } } while (0)

struct XcdBarrier {
    unsigned* bar; unsigned x;
    volatile LAS unsigned* st;
};

__device__ __forceinline__ XcdBarrier xcd_barrier_post(unsigned* bar, volatile LAS unsigned* st) {
    XcdBarrier b; b.bar = bar; b.x = xb_xcc_id(); b.st = st;
    if (threadIdx.x == 0) (void)xb_add(&bar[XB_XCNT(b.x)], 1u);
    return b;
}
__device__ __forceinline__ void xcd_barrier_complete(unsigned* bar, unsigned x, unsigned& nloc, unsigned& nx) {
    const unsigned G = gridDim.x * gridDim.y * gridDim.z;
    unsigned sum, cnt, mine, sp = 0u;
    for (;;) {
        sum = 0u; cnt = 0u; mine = 0u;
#pragma unroll
        for (unsigned j = 0; j < 16; ++j) { const unsigned c = xb_ld(&bar[XB_XCNT(j)]); sum += c; cnt += (c > 0u) ? 1u : 0u; mine = (j == x) ? c : mine; }
        if (sum == G) break;
        __builtin_amdgcn_s_sleep(1);
        if ((++sp & 255u) == 0u) { if (xb_ld(&bar[XB_TMO])) break; if (sp > XB_SPIN_CAP) { atomicAdd(&bar[XB_TMO], 1u); break; } }
    }
    nloc = mine > 0u ? mine : 1u; nx = cnt > 0u ? cnt : 1u;
}

__device__ __forceinline__ void xcd_barrier(const XcdBarrier& b) {
    asm volatile("s_waitcnt vmcnt(0)" ::: "memory");
    __syncthreads();
    if (threadIdx.x == 0) {
        unsigned* bar = b.bar;
        __builtin_amdgcn_s_waitcnt(0);
        unsigned nloc = b.st[0], nx = b.st[1];
        if (nloc == 0u) { xcd_barrier_complete(bar, b.x, nloc, nx); b.st[0] = nloc; b.st[1] = nx; }
        const unsigned old = xb_add(&bar[XB_XSUB(b.x)], 1u);
        const unsigned gen = old / nloc;
        if (old + 1u == (gen + 1u) * nloc) {
            __builtin_amdgcn_fence(__ATOMIC_RELEASE, "agent");
            asm volatile("s_waitcnt vmcnt(0)" ::: "memory");
            const unsigned og = xb_add(&bar[XB_TOP], 1u);
            const unsigned tg = og / nx;
            if (og + 1u == (tg + 1u) * nx) xb_add(&bar[XB_TOPGEN], 1u);
            else XB_SPIN(xb_ld(&bar[XB_TOPGEN]) == tg, bar);
            __builtin_amdgcn_fence(__ATOMIC_ACQUIRE, "agent");
            xb_add(&bar[XB_XGEN(b.x)], 1u);
            asm volatile("s_waitcnt vmcnt(0)" ::: "memory");
        } else {
            XB_SPIN(xb_ld(&bar[XB_XGEN(b.x)]) == gen, bar);
            __builtin_amdgcn_fence(__ATOMIC_ACQUIRE, "agent");
            asm volatile("s_waitcnt vmcnt(0)" ::: "memory");
        }
    }
    __syncthreads();
}

typedef short s16x4 __attribute__((ext_vector_type(4)));
typedef unsigned u32x2v __attribute__((ext_vector_type(2)));
__device__ __forceinline__ float bf_lo(unsigned w) { return __uint_as_float(w << 16); }
__device__ __forceinline__ float bf_hi(unsigned w) { return __uint_as_float(w & 0xffff0000u); }
__device__ __forceinline__ void unpack8(const v4u w, float (&f)[8]) {
    f[0] = bf_lo(w.x); f[1] = bf_hi(w.x); f[2] = bf_lo(w.y); f[3] = bf_hi(w.y); f[4] = bf_lo(w.z); f[5] = bf_hi(w.z); f[6] = bf_lo(w.w); f[7] = bf_hi(w.w); }
__device__ __forceinline__ v4u pack8(const float (&f)[8]) { v4u w; w.x = pk2(f[0], f[1]); w.y = pk2(f[2], f[3]); w.z = pk2(f[4], f[5]); w.w = pk2(f[6], f[7]); return w; }
__device__ __forceinline__ float wave_sum(float v) {
#pragma unroll
    for (int o = 1; o < 64; o <<= 1) v += __shfl_xor(v, o);
    return v;
}
__device__ __forceinline__ float wave_max(float v) {
#pragma unroll
    for (int o = 1; o < 64; o <<= 1) v = fmaxf(v, __shfl_xor(v, o));
    return v;
}
constexpr int TP_PITCH = 144;
__device__ __forceinline__ void p0_transpose_item(const float* W, int K, int N, bf16* WT, LAS unsigned char* scr, int item, int lane, const float* gain) {
    const int nq = N / 256, sup = item >> 3, w8 = item & 7, kb = 2 * (sup / nq) + (w8 >> 2), nb = 4 * (sup % nq) + (w8 & 3), k0 = 64 * kb, n0 = 64 * nb;
    const int lr = lane >> 4, lc = lane & 15;
    f32x4 v[16]; float g[16];
#pragma unroll
    for (int i = 0; i < 16; ++i) { v[i] = *(const GAS f32x4*)(W + (size_t)(k0 + 4 * i + lr) * N + n0 + 4 * lc); g[i] = gain ? gain[k0 + 4 * i + lr] : 1.0f; }
#pragma unroll
    for (int i = 0; i < 16; ++i) { u32x2v w; w.x = pk2(v[i].x * g[i], v[i].y * g[i]); w.y = pk2(v[i].z * g[i], v[i].w * g[i]); *(LAS u32x2v*)(scr + (4 * i + lr) * TP_PITCH + lc * 8) = w; }
    LDS_WAIT(); asm volatile("" ::: "memory");
    const int G4 = lane >> 4, q4 = (lane >> 2) & 3, p4 = lane & 3;
#pragma unroll
    for (int nbk = 0; nbk < 4; ++nbk)
#pragma unroll
        for (int kh = 0; kh < 2; ++kh) {
            const unsigned addr = (unsigned)(uintptr_t)scr + (unsigned)((32 * kh + 8 * G4 + q4) * TP_PITCH + (16 * nbk + 4 * p4) * 2);
            s16x4 lo, hi;
            asm volatile("ds_read_b64_tr_b16 %0, %2\n\tds_read_b64_tr_b16 %1, %2 offset:%3\n\ts_waitcnt lgkmcnt(0)" : "=&v"(lo), "=&v"(hi) : "v"(addr), "i"(4 * TP_PITCH) : "memory");
            const bf16x8 o = (bf16x8){lo[0], lo[1], lo[2], lo[3], hi[0], hi[1], hi[2], hi[3]};
            *(GAS bf16x8*)(WT + (size_t)(n0 + 16 * nbk + (lane & 15)) * K + k0 + 32 * kh + 8 * G4) = o;
        }
    asm volatile("" ::: "memory");
}
__device__ __forceinline__ void up_absmax_item(const float* W, int K, int N, unsigned* CMAX, int item, int lane, const float* gain, int ldw = 0) {
    if (ldw == 0) ldw = N;
    const int nq = N / 256, sup = item >> 3, w8 = item & 7, kb = 2 * (sup / nq) + (w8 >> 2), nb = 4 * (sup % nq) + (w8 & 3), k0 = 64 * kb, n0 = 64 * nb;
    const int lr = lane >> 4, lc = lane & 15;
    f32x4 v[16]; float g[16];
#pragma unroll
    for (int i = 0; i < 16; ++i) { v[i] = *(const GAS f32x4*)(W + (size_t)(k0 + 4 * i + lr) * ldw + n0 + 4 * lc); g[i] = gain ? gain[k0 + 4 * i + lr] : 1.0f; }
    f32x4 mx = {0.f, 0.f, 0.f, 0.f};
#pragma unroll
    for (int i = 0; i < 16; ++i) { mx.x = fmaxf(mx.x, fabsf(v[i].x * g[i])); mx.y = fmaxf(mx.y, fabsf(v[i].y * g[i])); mx.z = fmaxf(mx.z, fabsf(v[i].z * g[i])); mx.w = fmaxf(mx.w, fabsf(v[i].w * g[i])); }
#pragma unroll
    for (int e = 0; e < 4; ++e) { mx[e] = fmaxf(mx[e], __shfl_xor(mx[e], 16)); mx[e] = fmaxf(mx[e], __shfl_xor(mx[e], 32)); }
    if (lr == 0) {
#pragma unroll
        for (int e = 0; e < 4; ++e) atomicMax(CMAX + n0 + 4 * lc + e, __float_as_uint(mx[e])); }
}
__device__ __forceinline__ unsigned q4_pack(float a, float b, float c, float d) {
    unsigned r = 0u;
    r = __builtin_amdgcn_cvt_pk_u8_f32(a + 128.f, 0, r); r = __builtin_amdgcn_cvt_pk_u8_f32(b + 128.f, 1, r); r = __builtin_amdgcn_cvt_pk_u8_f32(c + 128.f, 2, r); r = __builtin_amdgcn_cvt_pk_u8_f32(d + 128.f, 3, r);
    return r ^ 0x80808080u;
}
__device__ __forceinline__ void up_quant_item(const float* W, int K, int N, signed char* WQ, const float* CMAXF, LAS unsigned char* scr, int item, int lane, const float* gain, int* CSUM = nullptr, int ldw = 0) {
    if (ldw == 0) ldw = N;
    const int nq = N / 256, sup = item >> 3, w8 = item & 7, kb = 2 * (sup / nq) + (w8 >> 2), nb = 4 * (sup % nq) + (w8 & 3), k0 = 64 * kb, n0 = 64 * nb;
    const int lr = lane >> 4, lc = lane & 15;
    f32x4 v[16]; float g[16];
#pragma unroll
    for (int i = 0; i < 16; ++i) { v[i] = *(const GAS f32x4*)(W + (size_t)(k0 + 4 * i + lr) * ldw + n0 + 4 * lc); g[i] = gain ? gain[k0 + 4 * i + lr] : 1.0f; }
    const f32x4 cm = *(const GAS f32x4*)(CMAXF + n0 + 4 * lc);
    f32x4 inv; inv.x = cm.x > 0.f ? 127.0f / cm.x : 0.f; inv.y = cm.y > 0.f ? 127.0f / cm.y : 0.f; inv.z = cm.z > 0.f ? 127.0f / cm.z : 0.f; inv.w = cm.w > 0.f ? 127.0f / cm.w : 0.f;
    f32x4 csum = {0.f, 0.f, 0.f, 0.f};
#pragma unroll
    for (int i = 0; i < 16; ++i) { const f32x4 q = {__builtin_rintf(v[i].x * g[i] * inv.x), __builtin_rintf(v[i].y * g[i] * inv.y), __builtin_rintf(v[i].z * g[i] * inv.z), __builtin_rintf(v[i].w * g[i] * inv.w)};
        csum = csum + q;
        u32x2v w; w.x = pk2(q.x, q.y); w.y = pk2(q.z, q.w);
        *(LAS u32x2v*)(scr + (4 * i + lr) * TP_PITCH + lc * 8) = w; }
    if (CSUM) {
#pragma unroll
        for (int e = 0; e < 4; ++e) { csum[e] += __shfl_xor(csum[e], 16); csum[e] += __shfl_xor(csum[e], 32); }
        if (lr == 0) {
#pragma unroll
            for (int e = 0; e < 4; ++e) atomicAdd(CSUM + n0 + 4 * lc + e, (int)csum[e]); } }
    LDS_WAIT(); asm volatile("" ::: "memory");
    const int G4 = lane >> 4, q4 = (lane >> 2) & 3, p4 = lane & 3;
#pragma unroll
    for (int nbk = 0; nbk < 4; ++nbk)
#pragma unroll
        for (int kh = 0; kh < 2; ++kh) {
            const unsigned addr = (unsigned)(uintptr_t)scr + (unsigned)((32 * kh + 8 * G4 + q4) * TP_PITCH + (16 * nbk + 4 * p4) * 2);
            s16x4 lo, hi;
            asm volatile("ds_read_b64_tr_b16 %0, %2\n\tds_read_b64_tr_b16 %1, %2 offset:%3\n\ts_waitcnt lgkmcnt(0)" : "=&v"(lo), "=&v"(hi) : "v"(addr), "i"(4 * TP_PITCH) : "memory");
#define BF_F(S) __uint_as_float((unsigned)(unsigned short)(S) << 16)
            u32x2v o; o.x = q4_pack(BF_F(lo[0]), BF_F(lo[1]), BF_F(lo[2]), BF_F(lo[3])); o.y = q4_pack(BF_F(hi[0]), BF_F(hi[1]), BF_F(hi[2]), BF_F(hi[3]));
#undef BF_F
            *(GAS u32x2v*)(WQ + (size_t)(n0 + 16 * nbk + (lane & 15)) * K + k0 + 32 * kh + 8 * G4) = o;
        }
    asm volatile("" ::: "memory");
}
__device__ __forceinline__ void hq_rows(bf16* HID, float* HROWS, int gw, int ngw, int lane) {
    asm volatile("" : "+v"(lane));
    for (int m = M - ngw + gw; m >= 0; m -= ngw) {
        bf16* slot = HID + (size_t)(m >> 8) * (32 * 65536) + (size_t)(m & 255) * 256 + (size_t)(lane >> 5) * 65536;
        v4u v[16];
#pragma unroll
        for (int j = 0; j < 16; ++j) v[j] = *(const GAS v4u*)(slot + (size_t)j * (2 * 65536) + (lane & 31) * 8);
        float amax = 0.f;
#pragma unroll
        for (int j = 0; j < 16; ++j)
#pragma unroll
            for (int c = 0; c < 4; ++c) { const unsigned w = v[j][c]; amax = fmaxf(amax, fmaxf(__uint_as_float(w << 16), __uint_as_float(w & 0xffff0000u))); }
        amax = wave_max(amax);
        const float inv = amax > 0.f ? 255.0f / amax : 0.f;
#pragma unroll
        for (int j = 0; j < 16; ++j) { unsigned o[2];
#pragma unroll
            for (int h = 0; h < 2; ++h) { const unsigned w0 = v[j][2 * h], w1 = v[j][2 * h + 1]; unsigned r = 0u;
                r = __builtin_amdgcn_cvt_pk_u8_f32(__builtin_rintf(__uint_as_float(w0 << 16) * inv), 0, r); r = __builtin_amdgcn_cvt_pk_u8_f32(__builtin_rintf(__uint_as_float(w0 & 0xffff0000u) * inv), 1, r);
                r = __builtin_amdgcn_cvt_pk_u8_f32(__builtin_rintf(__uint_as_float(w1 << 16) * inv), 2, r); r = __builtin_amdgcn_cvt_pk_u8_f32(__builtin_rintf(__uint_as_float(w1 & 0xffff0000u) * inv), 3, r);
                o[h] = r ^ 0x80808080u; }
            u32x2v ov; ov.x = o[0]; ov.y = o[1];
            *(GAS u32x2v*)((char*)(slot + (size_t)j * (2 * 65536)) + (lane & 31) * 8) = ov; }
        if (lane == 0) HROWS[m] = amax * (1.0f / 255.0f);
    }
}
template <bool NORM> __device__ __forceinline__ void xq_rows(const bf16* XB, signed char* XQ, float* ROWS, int gw, int ngw, int lane) {
    asm volatile("" : "+v"(lane));
    for (int m = 2 * gw; m < M; m += 2 * ngw) {
        const GAS v4u* xr = (const GAS v4u*)(XB + (size_t)m * DM) + lane;
        v4u v[2][4];
#pragma unroll
        for (int j = 0; j < 4; ++j) { v[0][j] = xr[64 * j]; v[1][j] = xr[DM / 8 + 64 * j]; }
#pragma unroll
        for (int r = 0; r < 2; ++r) {
            float f[4][8]; float amax = 0.f, ss = 0.f;
#pragma unroll
            for (int j = 0; j < 4; ++j)
#pragma unroll
                for (int c = 0; c < 4; ++c) { const unsigned w = v[r][j][c]; f[j][2 * c] = __uint_as_float(w << 16); f[j][2 * c + 1] = __uint_as_float(w & 0xffff0000u); }
#pragma unroll
            for (int j = 0; j < 4; ++j)
#pragma unroll
                for (int c = 0; c < 8; ++c) { amax = fmaxf(amax, fabsf(f[j][c])); ss += f[j][c] * f[j][c]; }
            amax = wave_max(amax); ss = wave_sum(ss);
            const float inv = amax > 0.f ? 127.0f / amax : 0.f;
            GAS u32x2v* o8 = (GAS u32x2v*)(XQ + (size_t)(m + r) * DM) + lane;
#pragma unroll
            for (int j = 0; j < 4; ++j) { u32x2v o;
                o.x = q4_pack(__builtin_rintf(f[j][0] * inv), __builtin_rintf(f[j][1] * inv), __builtin_rintf(f[j][2] * inv), __builtin_rintf(f[j][3] * inv));
                o.y = q4_pack(__builtin_rintf(f[j][4] * inv), __builtin_rintf(f[j][5] * inv), __builtin_rintf(f[j][6] * inv), __builtin_rintf(f[j][7] * inv));
                o8[64 * j] = o; }
            if (lane == 0) ROWS[m + r] = amax * (1.0f / 127.0f) * (NORM ? 1.0f / sqrtf(ss * (1.0f / DM) + EPS) : 1.0f);
        }
    }
}
__device__ __forceinline__ void xb_rows(const float* X, bf16* XB, float* RSS, signed char* XQ, float* ROWS, int gw, int ngw, int lane) {
    for (int m = 2 * gw; m < M; m += 2 * ngw) {
        const GAS f32x4* xr = (const GAS f32x4*)(X + (size_t)m * DM) + lane;
        f32x4 v[2][8]; float s0 = 0.f, s1 = 0.f;
#pragma unroll
        for (int j = 0; j < 8; ++j) { v[0][j] = xr[64 * j]; v[1][j] = xr[DM / 4 + 64 * j]; }
#pragma unroll
        for (int j = 0; j < 8; ++j) { s0 += (v[0][j].x * v[0][j].x + v[0][j].y * v[0][j].y) + (v[0][j].z * v[0][j].z + v[0][j].w * v[0][j].w);
                                      s1 += (v[1][j].x * v[1][j].x + v[1][j].y * v[1][j].y) + (v[1][j].z * v[1][j].z + v[1][j].w * v[1][j].w); }
        s0 = wave_sum(s0); s1 = wave_sum(s1);
        {
            float a0 = 0.f, a1 = 0.f;
#pragma unroll
            for (int j = 0; j < 8; ++j) { a0 = fmaxf(a0, fmaxf(fmaxf(fabsf(v[0][j].x), fabsf(v[0][j].y)), fmaxf(fabsf(v[0][j].z), fabsf(v[0][j].w))));
                                          a1 = fmaxf(a1, fmaxf(fmaxf(fabsf(v[1][j].x), fabsf(v[1][j].y)), fmaxf(fabsf(v[1][j].z), fabsf(v[1][j].w)))); }
            a0 = wave_max(a0); a1 = wave_max(a1);
            const float i0 = a0 > 0.f ? 127.0f / a0 : 0.f, i1 = a1 > 0.f ? 127.0f / a1 : 0.f;
            GAS unsigned* q0 = (GAS unsigned*)(XQ + (size_t)m * DM) + lane; GAS unsigned* q1 = (GAS unsigned*)(XQ + (size_t)(m + 1) * DM) + lane;
#pragma unroll
            for (int j = 0; j < 8; ++j) { q0[64 * j] = q4_pack(__builtin_rintf(v[0][j].x * i0), __builtin_rintf(v[0][j].y * i0), __builtin_rintf(v[0][j].z * i0), __builtin_rintf(v[0][j].w * i0));
                                          q1[64 * j] = q4_pack(__builtin_rintf(v[1][j].x * i1), __builtin_rintf(v[1][j].y * i1), __builtin_rintf(v[1][j].z * i1), __builtin_rintf(v[1][j].w * i1)); }
            if (lane == 0) { ROWS[m] = a0 * (1.0f / 127.0f) * (1.0f / sqrtf(s0 * (1.0f / DM) + EPS)); ROWS[m + 1] = a1 * (1.0f / 127.0f) * (1.0f / sqrtf(s1 * (1.0f / DM) + EPS)); }
        }
        GAS u32x2v* o8 = (GAS u32x2v*)(XB + (size_t)m * DM) + lane;
#pragma unroll
        for (int j = 0; j < 8; ++j) { u32x2v w; w.x = pk2(v[0][j].x, v[0][j].y); w.y = pk2(v[0][j].z, v[0][j].w); o8[64 * j] = w;
                                      u32x2v w1; w1.x = pk2(v[1][j].x, v[1][j].y); w1.y = pk2(v[1][j].z, v[1][j].w); o8[DM / 4 + 64 * j] = w1; }
        if (lane < pg8::RSS_PER_ROW) { RSS[(size_t)m * pg8::RSS_PER_ROW + lane] = (lane == 0) ? s0 : 0.f; RSS[(size_t)(m + 1) * pg8::RSS_PER_ROW + lane] = (lane == 0) ? s1 : 0.f; }
    }
}
constexpr int VN_PITCH = 544;
__device__ __forceinline__ void mixer_unit(int unit, const bf16* Z, bf16* CAT, const float* conv_w, const float* sgu_gain, const bf16* WSB, const float* b_s, LAS unsigned char* lds, int tid) {
    const int m0 = unit * SGC, lane = tid & 63, wid = tid >> 6;
    {
        const int cc = tid & 127, rg = tid >> 7, ch0 = 8 * cc;
        float w0[8], w1[8], w2[8];
#pragma unroll
        for (int e = 0; e < 8; ++e) { w0[e] = conv_w[(ch0 + e) * 3 + 0]; w1[e] = conv_w[(ch0 + e) * 3 + 1]; w2[e] = conv_w[(ch0 + e) * 3 + 2]; }
        const int mf = m0 + 32 * rg;
        float ym2[8], ym1[8];
#pragma unroll
        for (int e = 0; e < 8; ++e) { ym2[e] = 0.f; ym1[e] = 0.f; }
        if ((mf % SEQ) >= 2) {
            float a[8], b[8];
            unpack8(*(const GAS v4u*)(Z + (size_t)(mf - 2) * NMIX + CW + ch0), a); unpack8(*(const GAS v4u*)(Z + (size_t)(mf - 2) * NMIX + 2 * CW + ch0), b);
#pragma unroll
            for (int e = 0; e < 8; ++e) ym2[e] = a[e] * b[e];
            unpack8(*(const GAS v4u*)(Z + (size_t)(mf - 1) * NMIX + CW + ch0), a); unpack8(*(const GAS v4u*)(Z + (size_t)(mf - 1) * NMIX + 2 * CW + ch0), b);
#pragma unroll
            for (int e = 0; e < 8; ++e) ym1[e] = a[e] * b[e];
        }
#pragma unroll 8
        for (int t = 0; t < 32; ++t) {
            const size_t m = (size_t)(mf + t);
            float gb[8], gc[8], xa[8], o[8];
            unpack8(*(const GAS v4u*)(Z + m * NMIX + ch0), gb); unpack8(*(const GAS v4u*)(Z + m * NMIX + CW + ch0), gc); unpack8(*(const GAS v4u*)(Z + m * NMIX + 2 * CW + ch0), xa);
#pragma unroll
            for (int e = 0; e < 8; ++e) { const float y = gc[e] * xa[e]; o[e] = gb[e] * (ym2[e] * w0[e] + ym1[e] * w1[e] + y * w2[e]); ym2[e] = ym1[e]; ym1[e] = y; }
            *(GAS v4u*)(CAT + m * DM + ch0) = pack8(o);
        }
    }
    constexpr int WL_OFF = 128 * VN_PITCH, WL_PITCH = 272;
    for (int gp = 0; gp < SGG; gp += 2) {
        {
            v4u vv[8], ww[8];
#pragma unroll
            for (int k = 0; k < 8; ++k) { const int p = tid + 512 * k, j = p >> 5, cp = p & 31;
                vv[k] = *(const GAS v4u*)(Z + (size_t)(m0 + j) * NMIX + 4 * CW + gp * SGD + cp * 8); }
#pragma unroll
            for (int k = 0; k < 8; ++k) { const int p = tid + 512 * k;
                ww[k] = *(const GAS v4u*)(WSB + (size_t)gp * 128 * 128 + (size_t)p * 8); }
#pragma unroll
            for (int k = 0; k < 8; ++k) { const int p = tid + 512 * k, j = p >> 5, cp = p & 31;
                float v[8]; unpack8(vv[k], v);
                float ss = 0.f;
#pragma unroll
                for (int e = 0; e < 8; ++e) ss += v[e] * v[e];
                ss += __shfl_xor(ss, 1); ss += __shfl_xor(ss, 2); ss += __shfl_xor(ss, 4); ss += __shfl_xor(ss, 8);
                const float rinv = 1.0f / sqrtf(ss * (1.0f / SGD) + EPS);
                const GAS f32x4* gp4 = (const GAS f32x4*)(sgu_gain + gp * SGD + cp * 8); const f32x4 g0 = gp4[0], g1 = gp4[1];
                float o[8] = {v[0] * rinv * g0.x, v[1] * rinv * g0.y, v[2] * rinv * g0.z, v[3] * rinv * g0.w, v[4] * rinv * g1.x, v[5] * rinv * g1.y, v[6] * rinv * g1.z, v[7] * rinv * g1.w};
                *(LAS v4u*)(lds + j * VN_PITCH + cp * 16) = pack8(o);
                *(LAS v4u*)(lds + WL_OFF + (p >> 4) * WL_PITCH + (p & 15) * 16) = ww[k]; }
        }
        LDS_WAIT(); __syncthreads();
        {
            const int gl = wid >> 2, g = gp + gl, dq = wid & 3;
            const int G4 = lane >> 4, q4 = (lane >> 2) & 3, p4 = lane & 3, fr = lane & 15;
            v4u uw[8];
#pragma unroll
            for (int it = 0; it < 8; ++it) uw[it] = *(const GAS v4u*)(Z + (size_t)(m0 + 16 * it + fr) * NMIX + 3 * CW + g * SGD + 32 * dq + 8 * G4);
            bf16x8 af[2][4];
#pragma unroll
            for (int dt = 0; dt < 2; ++dt)
#pragma unroll
                for (int ks = 0; ks < 4; ++ks) {
                    const unsigned addr = (unsigned)(uintptr_t)(lds) + (unsigned)((32 * ks + 8 * G4 + q4) * VN_PITCH + (gl * SGD + 32 * dq + 8 * p4 + 4 * dt) * 2);
                    s16x4 lo, hi;
                    asm volatile("ds_read_b64_tr_b16 %0, %2\n\tds_read_b64_tr_b16 %1, %2 offset:%3\n\ts_waitcnt lgkmcnt(0)" : "=&v"(lo), "=&v"(hi) : "v"(addr), "i"(4 * VN_PITCH) : "memory");
                    af[dt][ks] = (bf16x8){lo[0], lo[1], lo[2], lo[3], hi[0], hi[1], hi[2], hi[3]};
                }
            __builtin_amdgcn_sched_barrier(0);
#pragma unroll
            for (int it = 0; it < 8; ++it) {
                const int nks = it / 2 + 1;
                bf16x8 bfr[4];
#pragma unroll
                for (int ks = 0; ks < 4; ++ks) if (ks < nks) bfr[ks] = *(const LAS bf16x8*)(lds + WL_OFF + (gl * 128 + 16 * it + fr) * WL_PITCH + (32 * ks + 8 * G4) * 2);
                const int mt = m0 + 16 * it + fr;
                const float bias = b_s[g * SGC + 16 * it + fr];
                v4u ow;
#pragma unroll
                for (int dt = 0; dt < 2; ++dt) {
                    f32x4 acc = {0.f, 0.f, 0.f, 0.f};
#pragma unroll
                    for (int ks = 0; ks < 4; ++ks) if (ks < nks) acc = __builtin_amdgcn_mfma_f32_16x16x32_bf16(af[dt][ks], bfr[ks], acc, 0, 0, 0);
                    const unsigned ua = dt ? uw[it].z : uw[it].x, ub = dt ? uw[it].w : uw[it].y;
                    const unsigned oa = pk2(bf_lo(ua) * (acc[0] + bias), bf_hi(ua) * (acc[1] + bias)), ob = pk2(bf_lo(ub) * (acc[2] + bias), bf_hi(ub) * (acc[3] + bias));
                    if (dt) { ow.z = oa; ow.w = ob; } else { ow.x = oa; ow.y = ob; }
                }
                *(GAS v4u*)(CAT + (size_t)mt * DM + CW + g * SGD + 32 * dq + 8 * G4) = ow;
            }
        }
        __syncthreads();
    }
}

namespace att {
typedef float f32x16 __attribute__((ext_vector_type(16)));
constexpr float SCALE = 0.08838834764831845f, LOG2E = 1.4426950408889634f, CS = SCALE * LOG2E;
constexpr int KT = 16384;
constexpr int LDS_K = 0, LDS_V = 4 * KT, LDS_LIST = 8 * KT, LIST_CAP = 8192, LDS_CNT = LDS_LIST + 2 * LIST_CAP;
#define KSWZ(row, colB) ((row) * 256 + ((colB) ^ (((row) & 7) << 4)))
#define SBAR() __builtin_amdgcn_sched_barrier(0)
__device__ __forceinline__ int crow(int r, int hi) { return (r & 3) + 8 * (r >> 2) + 4 * hi; }
__device__ __forceinline__ unsigned cvtpk(float lo, float hi) { unsigned r; asm volatile("v_cvt_pk_bf16_f32 %0, %1, %2" : "=v"(r) : "v"(lo), "v"(hi)); return r; }
__device__ __forceinline__ int v_st(int k, int c) { const int kk = (k & ~0xC) | ((k & 4) << 1) | ((k & 8) >> 1); return ((kk >> 3) * 4 + (c >> 5)) * 512 + ((kk & 7) * 32 + (c & 31)) * 2; }
__device__ __forceinline__ int v_rd_base(int lane) { return ((lane & 3) << 3) | (((lane >> 2) & 3) << 6) | (((lane >> 4) & 1) << 5) | (((lane >> 5) & 1) << 8); }
constexpr int v_rd_off(int d0, int ks, int half) { return d0 * 512 + ks * 4096 + half * 2048; }
template <int OFF> __device__ __forceinline__ s16x4 tr_read(int vb) { s16x4 r; asm volatile("ds_read_b64_tr_b16 %0, %1 offset:%2" : "=&v"(r) : "v"(vb), "i"(OFF) : "memory"); return r; }
__device__ __forceinline__ void qkt(f32x16& p0, f32x16& p1, const LAS unsigned char* Ks, const bf16x8 (&qr)[8], int r32, int hi) {
    p0 = (f32x16){}; p1 = (f32x16){};
#pragma unroll
    for (int d0 = 0; d0 < 8; ++d0) { const int cb = (d0 * 16 + hi * 8) * 2;
        const bf16x8 b0 = *(const LAS bf16x8*)(Ks + KSWZ(r32, cb));
        const bf16x8 b1 = *(const LAS bf16x8*)(Ks + KSWZ(32 + r32, cb));
        p0 = __builtin_amdgcn_mfma_f32_32x32x16_bf16(b0, qr[d0], p0, 0, 0, 0);
        p1 = __builtin_amdgcn_mfma_f32_32x32x16_bf16(b1, qr[d0], p1, 0, 0, 0); }
}
template <int D0> __device__ __forceinline__ void pv_one(f32x16& od, int vb, bf16x8 pa0, bf16x8 pa1, bf16x8 pa2, bf16x8 pa3) {
    const s16x4 l0 = tr_read<v_rd_off(D0, 0, 0)>(vb), h0 = tr_read<v_rd_off(D0, 0, 1)>(vb), l1 = tr_read<v_rd_off(D0, 1, 0)>(vb), h1 = tr_read<v_rd_off(D0, 1, 1)>(vb);
    const s16x4 l2 = tr_read<v_rd_off(D0, 2, 0)>(vb), h2 = tr_read<v_rd_off(D0, 2, 1)>(vb), l3 = tr_read<v_rd_off(D0, 3, 0)>(vb), h3 = tr_read<v_rd_off(D0, 3, 1)>(vb);
    asm volatile("s_waitcnt lgkmcnt(0)" ::: "memory"); SBAR();
#define PK(L, H) (bf16x8){L[0], L[1], L[2], L[3], H[0], H[1], H[2], H[3]}
    od = __builtin_amdgcn_mfma_f32_32x32x16_bf16(PK(l0, h0), pa0, od, 0, 0, 0);
    od = __builtin_amdgcn_mfma_f32_32x32x16_bf16(PK(l1, h1), pa1, od, 0, 0, 0);
    od = __builtin_amdgcn_mfma_f32_32x32x16_bf16(PK(l2, h2), pa2, od, 0, 0, 0);
    od = __builtin_amdgcn_mfma_f32_32x32x16_bf16(PK(l3, h3), pa3, od, 0, 0, 0);
#undef PK
}
template <int D0, int HH> __device__ __forceinline__ void pv_half(f32x16& od, int vb, bf16x8 pa0, bf16x8 pa1) {
    const s16x4 l0 = tr_read<v_rd_off(D0, 2 * HH, 0)>(vb), h0 = tr_read<v_rd_off(D0, 2 * HH, 1)>(vb), l1 = tr_read<v_rd_off(D0, 2 * HH + 1, 0)>(vb), h1 = tr_read<v_rd_off(D0, 2 * HH + 1, 1)>(vb);
    asm volatile("s_waitcnt lgkmcnt(0)" ::: "memory"); SBAR();
#define PK(L, H) (bf16x8){L[0], L[1], L[2], L[3], H[0], H[1], H[2], H[3]}
    od = __builtin_amdgcn_mfma_f32_32x32x16_bf16(PK(l0, h0), pa0, od, 0, 0, 0);
    od = __builtin_amdgcn_mfma_f32_32x32x16_bf16(PK(l1, h1), pa1, od, 0, 0, 0);
#undef PK
}
template <bool MASK, int HH> __device__ __forceinline__ void half_step(f32x16 (&oT)[4], float& lsum, const LAS unsigned char* Ks, int vb, const bf16x8 (&qr)[8], float qterm, float sl2, int qrel, int r32, int hi) {
    f32x16 p = (f32x16){};
#pragma unroll
    for (int d0 = 0; d0 < 8; ++d0) { const int cb = (d0 * 16 + hi * 8) * 2;
        const bf16x8 b0 = *(const LAS bf16x8*)(Ks + KSWZ(32 * HH + r32, cb));
        p = __builtin_amdgcn_mfma_f32_32x32x16_bf16(b0, qr[d0], p, 0, 0, 0); }
    const float base = qterm + sl2 * (float)(4 * hi + 32 * HH);
    float ps = 0.f;
#pragma unroll
    for (int r = 0; r < 16; ++r) { const int kk = (r & 3) + 8 * (r >> 2);
        float a0 = fmaf(p[r], CS, fmaf(sl2, (float)kk, base));
        if (MASK) { const unsigned m0_ = (unsigned)((qrel - (kk + 4 * hi + 32 * HH)) >> 31);
            a0 = __uint_as_float((__float_as_uint(a0) & ~m0_) | (0xff800000u & m0_)); }
        p[r] = __builtin_amdgcn_exp2f(a0); ps += p[r]; }
    lsum += ps;
    bf16x8 pa0, pa1;
#define PK4(P, BASE, OUT) do { unsigned a0_ = cvtpk(P[BASE + 0], P[BASE + 1]), a1_ = cvtpk(P[BASE + 2], P[BASE + 3]);   \
    unsigned b0_ = cvtpk(P[BASE + 4], P[BASE + 5]), b1_ = cvtpk(P[BASE + 6], P[BASE + 7]);                              \
    auto r0_ = __builtin_amdgcn_permlane32_swap(a0_, b0_, false, false); auto r1_ = __builtin_amdgcn_permlane32_swap(a1_, b1_, false, false); \
    v4u w_ = {r0_[0], r1_[0], r0_[1], r1_[1]}; OUT = __builtin_bit_cast(bf16x8, w_); } while (0)
    PK4(p, 0, pa0); PK4(p, 8, pa1);
#undef PK4
    pv_half<0, HH>(oT[0], vb, pa0, pa1); pv_half<1, HH>(oT[1], vb, pa0, pa1); pv_half<2, HH>(oT[2], vb, pa0, pa1); pv_half<3, HH>(oT[3], vb, pa0, pa1);
}
template <bool MASK> __device__ __forceinline__ void tile_step(f32x16 (&oT)[4], float& lsum, const LAS unsigned char* Ks, int vb, const bf16x8 (&qr)[8], float qterm, float sl2, int qrel, int r32, int hi) {
    half_step<MASK, 0>(oT, lsum, Ks, vb, qr, qterm, sl2, qrel, r32, hi);
    half_step<MASK, 1>(oT, lsum, Ks, vb, qr, qterm, sl2, qrel, r32, hi);
}
struct Stg { v4u k0, k1, v0, v1; };
__device__ __forceinline__ void stage_load(Stg& s, const bf16* Kg, const bf16* Vg, size_t krow0, int hc, int tid) {
    const int sr = tid >> 4, sc = (tid & 15) * 8;
    const size_t o0 = (krow0 + sr) * DM + hc + sc, o1 = (krow0 + 32 + sr) * DM + hc + sc;
    s.k0 = *(const GAS v4u*)(Kg + o0); s.k1 = *(const GAS v4u*)(Kg + o1); s.v0 = *(const GAS v4u*)(Vg + o0); s.v1 = *(const GAS v4u*)(Vg + o1);
}
__device__ __forceinline__ void stage_write(const Stg& s, LAS unsigned char* Kb, LAS unsigned char* Vb, int tid) {
    const int sr = tid >> 4, sc = (tid & 15) * 8;
    *(LAS v4u*)(Kb + KSWZ(sr, sc * 2)) = s.k0; *(LAS v4u*)(Kb + KSWZ(32 + sr, sc * 2)) = s.k1;
    *(LAS v4u*)(Vb + v_st(sr, sc)) = s.v0; *(LAS v4u*)(Vb + v_st(32 + sr, sc)) = s.v1;
}
__device__ __forceinline__ void block_stage_issue(Stg (&s)[4], const bf16* Kg, const bf16* Vg, size_t krow0, int hc, int tid) {
    asm volatile("" : "+v"(tid));
#pragma unroll
    for (int t = 0; t < 4; ++t) stage_load(s[t], Kg, Vg, krow0 + 64 * t, hc, tid);
}
__device__ __forceinline__ void block_stage_finish(const Stg (&s)[4], LAS unsigned char* lds, int tid) {
    asm volatile("" : "+v"(tid));
#pragma unroll
    for (int t = 0; t < 4; ++t) stage_write(s[t], lds + LDS_K + t * KT, lds + LDS_V + t * KT, tid);
    LDS_WAIT(); __syncthreads();
}
__device__ __forceinline__ void block_stage(const bf16* Kg, const bf16* Vg, size_t krow0, int hc, LAS unsigned char* lds, int tid) {
    Stg s[4]; block_stage_issue(s, Kg, Vg, krow0, hc, tid); block_stage_finish(s, lds, tid);
}
template <bool CAUSAL> __device__ __forceinline__ void block_tiles(f32x16 (&oT)[4], float& lsum, const bf16x8 (&qr)[8], int t_minus_kb, int qin, int ntile_w, float sl2, float mref2,
                                                                 LAS unsigned char* lds, int r32, int hi, int lane) {
    const int vb0 = (int)(unsigned)(uintptr_t)(lds + LDS_V) + v_rd_base(lane);
#pragma unroll 1
    for (int t = 0; t < ntile_w; ++t) {
        const float qterm = -sl2 * (float)(t_minus_kb - 64 * t) - mref2;
        tile_step<CAUSAL>(oT, lsum, lds + LDS_K + t * KT, vb0 + t * KT, qr, qterm, sl2, qin - 64 * t, r32, hi);
    }
}
__device__ __forceinline__ v4u pair16(u32x2v a  , u32x2v b  ) {
    const auto rx = __builtin_amdgcn_permlane32_swap(a.x, b.x, false, false); const auto ry = __builtin_amdgcn_permlane32_swap(a.y, b.y, false, false);
    return (v4u){rx[0], ry[0], rx[1], ry[1]};
}
__device__ __forceinline__ void unpair16(v4u w, u32x2v& a  , u32x2v& b  ) {
    const auto rx = __builtin_amdgcn_permlane32_swap(w.x, w.z, false, false); const auto ry = __builtin_amdgcn_permlane32_swap(w.y, w.w, false, false);
    a.x = rx[0]; a.y = ry[0]; b.x = rx[1]; b.y = ry[1];
}
template <int CTRL> __device__ __forceinline__ unsigned qdpp(unsigned v) { return (unsigned)__builtin_amdgcn_update_dpp(0, (int)v, CTRL, 0xF, 0xF, true); }
__device__ __forceinline__ void quad_t4(v4u& x0, v4u& x1, v4u& x2, v4u& x3, int lane) {
    asm volatile("" : "+v"(lane));
    const bool o1 = (lane & 1) != 0, o2 = (lane & 2) != 0;
#pragma unroll
    for (int c = 0; c < 4; ++c) {
        { const unsigned a = x0[c], b = x1[c], ta = qdpp<0xB1>(b), tb = qdpp<0xB1>(a); x0[c] = o1 ? ta : a; x1[c] = o1 ? b : tb; }
        { const unsigned a = x2[c], b = x3[c], ta = qdpp<0xB1>(b), tb = qdpp<0xB1>(a); x2[c] = o1 ? ta : a; x3[c] = o1 ? b : tb; }
        { const unsigned a = x0[c], b = x2[c], ta = qdpp<0x4E>(b), tb = qdpp<0x4E>(a); x0[c] = o2 ? ta : a; x2[c] = o2 ? b : tb; }
        { const unsigned a = x1[c], b = x3[c], ta = qdpp<0x4E>(b), tb = qdpp<0x4E>(a); x1[c] = o2 ? ta : a; x3[c] = o2 ? b : tb; }
    }
}
template <int JJ> __device__ __forceinline__ const bf16* quad_ptr(const bf16* p) {
    const unsigned long long u = (unsigned long long)(uintptr_t)p;
    const unsigned lo = qdpp<JJ * 0x55>((unsigned)u), hi = qdpp<JJ * 0x55>((unsigned)(u >> 32));
    return (const bf16*)(uintptr_t)(((unsigned long long)hi << 32) | lo);
}
__device__ __forceinline__ void rows_gather_issue(v4u (&x)[8], const bf16* myrowp, int ok, int lane) {
    asm volatile("" : "+v"(lane));
    const int c0 = (2 * (lane & 3) + (lane >> 5)) * 8;
    const bf16* p0 = quad_ptr<0>(myrowp); const bf16* p1 = quad_ptr<1>(myrowp); const bf16* p2 = quad_ptr<2>(myrowp); const bf16* p3 = quad_ptr<3>(myrowp);
    const int k0 = (int)qdpp<0x00>((unsigned)ok), k1 = (int)qdpp<0x55>((unsigned)ok), k2 = (int)qdpp<0xAA>((unsigned)ok), k3 = (int)qdpp<0xFF>((unsigned)ok);
    const v4u z = (v4u){0u, 0u, 0u, 0u};
    x[0] = k0 ? *(const GAS v4u*)(p0 + c0) : z; x[1] = k1 ? *(const GAS v4u*)(p1 + c0) : z; x[2] = k2 ? *(const GAS v4u*)(p2 + c0) : z; x[3] = k3 ? *(const GAS v4u*)(p3 + c0) : z;
    x[4] = k0 ? *(const GAS v4u*)(p0 + 64 + c0) : z; x[5] = k1 ? *(const GAS v4u*)(p1 + 64 + c0) : z; x[6] = k2 ? *(const GAS v4u*)(p2 + 64 + c0) : z; x[7] = k3 ? *(const GAS v4u*)(p3 + 64 + c0) : z;
}
__device__ __forceinline__ void rows_gather_finish(v4u (&x)[8], int lane) { quad_t4(x[0], x[1], x[2], x[3], lane); quad_t4(x[4], x[5], x[6], x[7], lane); }
__device__ __forceinline__ void rows_scatter(v4u (&x)[8], bf16* myrowp, int ok, int lane) {
    asm volatile("" : "+v"(lane));
    quad_t4(x[0], x[1], x[2], x[3], lane); quad_t4(x[4], x[5], x[6], x[7], lane);
    const int c0 = (2 * (lane & 3) + (lane >> 5)) * 8;
    bf16* p0 = (bf16*)quad_ptr<0>(myrowp); bf16* p1 = (bf16*)quad_ptr<1>(myrowp); bf16* p2 = (bf16*)quad_ptr<2>(myrowp); bf16* p3 = (bf16*)quad_ptr<3>(myrowp);
    const int k0 = (int)qdpp<0x00>((unsigned)ok), k1 = (int)qdpp<0x55>((unsigned)ok), k2 = (int)qdpp<0xAA>((unsigned)ok), k3 = (int)qdpp<0xFF>((unsigned)ok);
    if (k0) { *(GAS v4u*)(p0 + c0) = x[0]; *(GAS v4u*)(p0 + 64 + c0) = x[4]; }
    if (k1) { *(GAS v4u*)(p1 + c0) = x[1]; *(GAS v4u*)(p1 + 64 + c0) = x[5]; }
    if (k2) { *(GAS v4u*)(p2 + c0) = x[2]; *(GAS v4u*)(p2 + 64 + c0) = x[6]; }
    if (k3) { *(GAS v4u*)(p3 + c0) = x[3]; *(GAS v4u*)(p3 + 64 + c0) = x[7]; }
}
#define INS3(v, n) do { const bool a_ = (v) > v0, b_ = (v) > v1, c_ = (v) > v2; \
    v2 = b_ ? v1 : (c_ ? (v) : v2); n2 = b_ ? n1 : (c_ ? (n) : n2); v1 = a_ ? v0 : (b_ ? (v) : v1); n1 = a_ ? n0 : (b_ ? (n) : n1); v0 = a_ ? (v) : v0; n0 = a_ ? (n) : n0; } while (0)
__device__ __forceinline__ void gate_unit(int b, int h, int i, const bf16* Q, const float* KMP, unsigned* SEL, LAS unsigned char* lds, int tid) {
    const int lane = tid & 63, wid = __builtin_amdgcn_readfirstlane(tid >> 6), r32 = lane & 31, hi = lane >> 5;
    unsigned* selp = SEL + ((size_t)(b * NH + h) * SEQ + i * BLK + wid * 32 + r32);
    if (i == 0) { if (hi == 0) *selp = 0x00ffffffu; return; }
    bf16x8 qr[8];
    v4u qv[8]; rows_gather_issue(qv, Q + (size_t)(b * SEQ + i * BLK + wid * 32 + r32) * DM + h * HD, 1, lane);
    {
        const float* kb = KMP + ((size_t)(b * NH + h) * NBLK) * 2 * HD;
        f32x4 kv[8];
#pragma unroll
        for (int k = 0; k < 8; ++k) { const int n = wid + 8 * k;
            kv[k] = (n < i) ? *(const GAS f32x4*)(kb + (size_t)n * 2 * HD + lane * 4) : (f32x4){0.f, 0.f, 0.f, 0.f}; }
        rows_gather_finish(qv, lane);
#pragma unroll
        for (int d0 = 0; d0 < 8; ++d0) qr[d0] = __builtin_bit_cast(bf16x8, qv[d0]);
#pragma unroll
        for (int k = 0; k < 8; ++k) { const int n = wid + 8 * k, chunk = lane & 31;
            float hv[4];
#pragma unroll
            for (int e = 0; e < 4; ++e) { const float m = kv[k][e] + __shfl_xor(kv[k][e], 32); const float hb = __uint_as_float(f2bf(m) << 16); hv[e] = (lane < 32) ? hb : (m - hb); }
            u32x2v w; w.x = pk2(hv[0], hv[1]); w.y = pk2(hv[2], hv[3]);
            *(LAS u32x2v*)(lds + (lane < 32 ? 0 : KT) + n * 256 + ((((chunk >> 1) << 4) ^ ((n & 7) << 4)) + ((chunk & 1) << 3))) = w; }
    }
    LDS_WAIT(); __syncthreads();
    f32x16 g0, g1, l0, l1;
    qkt(g0, g1, lds, qr, r32, hi); qkt(l0, l1, lds + KT, qr, r32, hi);
    float v0 = -INFINITY, v1 = -INFINITY, v2 = -INFINITY; int n0 = 255, n1 = 255, n2 = 255;
#pragma unroll
    for (int r = 0; r < 16; ++r) { const int n = crow(r, hi); const float g = (n < i) ? g0[r] + l0[r] : -INFINITY; INS3(g, n); }
#pragma unroll
    for (int r = 0; r < 16; ++r) { const int n = 32 + crow(r, hi); const float g = (n < i) ? g1[r] + l1[r] : -INFINITY; INS3(g, n); }
    {
        const float pv0 = __shfl_xor(v0, 32), pv1 = __shfl_xor(v1, 32), pv2 = __shfl_xor(v2, 32);
        const int pn0 = __shfl_xor(n0, 32), pn1 = __shfl_xor(n1, 32), pn2 = __shfl_xor(n2, 32);
        INS3(pv0, pn0); INS3(pv1, pn1); INS3(pv2, pn2);
    }
    if (hi == 0) *selp = (unsigned)n0 | ((unsigned)n1 << 8) | ((unsigned)n2 << 16);
    __syncthreads();
}
#undef INS3
__device__ __forceinline__ int zero_dist(float sl2) { const float d = 160.0f / sl2; return d > 1.0e6f ? 1000000 : (int)d; }
__device__ __forceinline__ void sel_unit(int b, int h, int j, const bf16* Q, const bf16* K, const bf16* V, const unsigned* SEL, bf16* PO0, bf16* PO1, bf16* PO2, float* LS,
                                         float sl2, float mref2, LAS unsigned char* lds, int tid) {
    const int lane = tid & 63, wid = __builtin_amdgcn_readfirstlane(tid >> 6), r32 = lane & 31, hi = lane >> 5;
    LAS unsigned* cnt = (LAS unsigned*)(lds + LDS_CNT);
    LAS unsigned short* list = (LAS unsigned short*)(lds + LDS_LIST);
    const unsigned* selp = SEL + (size_t)(b * NH + h) * SEQ;
    const int s_first = BLK * (j + 1);
    const int s_last = BLK * j + (BLK - 1) + zero_dist(sl2);
    const int s_end = s_last + 1 < SEQ ? ((s_last + 1 + 255) & ~255) : SEQ;
    if (s_first >= s_end) return;
    bool staged = false;
    for (int s0 = s_first; s0 < s_end; s0 += LIST_CAP) {
        if (tid == 0) *cnt = 0u;
        LDS_WAIT(); __syncthreads();
        const int nscan = (s_end - s0) < LIST_CAP ? (s_end - s0) : LIST_CAP;
        v4u ev[LIST_CAP / 2048];
#pragma unroll
        for (int k = 0; k < LIST_CAP / 2048; ++k) { const int o = k * 2048 + tid * 4; ev[k] = (o < nscan) ? *(const GAS v4u*)(selp + s0 + o) : (v4u){~0u, ~0u, ~0u, ~0u}; }
#pragma unroll
        for (int k = 0; k < LIST_CAP / 2048; ++k) {
            if (k * 2048 < nscan) {
#pragma unroll
                for (int c = 0; c < 4; ++c) {
                    const unsigned e = ev[k][c]; const int s = s0 + k * 2048 + tid * 4 + c;
                    int slot = ((e & 255u) == (unsigned)j) ? 0 : ((((e >> 8) & 255u) == (unsigned)j) ? 1 : ((((e >> 16) & 255u) == (unsigned)j) ? 2 : -1));
                    if (s > s_last) slot = -1;
                    const unsigned long long mask = __ballot(slot >= 0);
                    if (mask) {
                        unsigned base_pos = 0;
                        if (lane == 0) base_pos = __hip_atomic_fetch_add(cnt, (unsigned)__popcll(mask), __ATOMIC_RELAXED, __HIP_MEMORY_SCOPE_WORKGROUP);
                        base_pos = __builtin_amdgcn_readfirstlane(base_pos);
                        if (slot >= 0) { const unsigned pos = base_pos + __builtin_amdgcn_mbcnt_hi((unsigned)(mask >> 32), __builtin_amdgcn_mbcnt_lo((unsigned)mask, 0u)); list[pos] = (unsigned short)(s | (slot << 14)); }
                    }
                }
            }
        }
        LDS_WAIT(); __syncthreads();
        const int L = (int)*cnt;
        v4u qn[8]; unsigned entn = 0u;
        if (wid * 32 < L) { const int idx = wid * 32 + r32; entn = list[idx < L ? idx : wid * 32];
            rows_gather_issue(qn, Q + ((size_t)b * SEQ + (entn & 0x3fffu)) * DM + h * HD, 1, lane); }
        if (L > 0 && !staged) { block_stage(K, V, (size_t)b * SEQ + (size_t)j * BLK, h * HD, lds, tid); staged = true; }
#pragma unroll 1
        for (int grp = wid; grp * 32 < L; grp += NWAVES) {
            const int valid = (grp * 32 + r32 < L) ? 1 : 0;
            const unsigned ent = entn;
            rows_gather_finish(qn, lane);
            bf16x8 qr[8];
#pragma unroll
            for (int d0 = 0; d0 < 8; ++d0) qr[d0] = __builtin_bit_cast(bf16x8, qn[d0]);
            if ((grp + NWAVES) * 32 < L) { const int idx = (grp + NWAVES) * 32 + r32; entn = list[idx < L ? idx : (grp + NWAVES) * 32];
                rows_gather_issue(qn, Q + ((size_t)b * SEQ + (entn & 0x3fffu)) * DM + h * HD, 1, lane); }
            const int s = ent & 0x3fff, slot = ent >> 14;
            const size_t m = (size_t)b * SEQ + s;
            f32x16 oT[4]; oT[0] = (f32x16){}; oT[1] = (f32x16){}; oT[2] = (f32x16){}; oT[3] = (f32x16){};
            float lsum = 0.f;
            block_tiles<false>(oT, lsum, qr, s - j * BLK, 0, 4, sl2, mref2, lds, r32, hi, lane);
            lsum += __shfl_xor(lsum, 32);
            v4u pc[8];
#pragma unroll
            for (int d0 = 0; d0 < 4; ++d0)
#pragma unroll
                for (int g = 0; g < 4; g += 2) { u32x2v wa, wb; wa.x = cvtpk(oT[d0][4 * g], oT[d0][4 * g + 1]); wa.y = cvtpk(oT[d0][4 * g + 2], oT[d0][4 * g + 3]);
                    wb.x = cvtpk(oT[d0][4 * g + 4], oT[d0][4 * g + 5]); wb.y = cvtpk(oT[d0][4 * g + 6], oT[d0][4 * g + 7]);
                    pc[2 * d0 + g / 2] = pair16(wa, wb); }
            rows_scatter(pc, (slot == 0 ? PO0 : (slot == 1 ? PO1 : PO2)) + m * DM + h * HD, valid, lane);
            if (valid && hi == 0) LS[(m * NH + h) * 4 + slot] = lsum;
        }
        __syncthreads();
    }
}
__device__ __forceinline__ void own_unit(int b, int h, int i, const bf16* Q, const bf16* K, const bf16* V, const bf16* PO0, const bf16* PO1, const bf16* PO2, const float* LS, const unsigned* SEL, bf16* AO,
                                         float sl2, float mref2, LAS unsigned char* lds, int tid, bool do_store = true) {
    const int lane = tid & 63, wid = __builtin_amdgcn_readfirstlane(tid >> 6), r32 = lane & 31, hi = lane >> 5;
    const size_t krow0 = (size_t)b * SEQ + (size_t)i * BLK, m = krow0 + wid * 32 + r32;
    const int nsel = i < 3 ? i : 3;
    const unsigned selw = nsel ? SEL[(size_t)(b * NH + h) * SEQ + i * BLK + wid * 32 + r32] : 0u;
    f32x16 oT[4]; oT[0] = (f32x16){}; oT[1] = (f32x16){}; oT[2] = (f32x16){}; oT[3] = (f32x16){};
    float lsel = 0.f;
    const int zd = zero_dist(sl2), spos = i * BLK + wid * 32 + r32;
#define OWN_KEEP(sl) (spos <= BLK * (int)((selw >> (8 * (sl))) & 255u) + (BLK - 1) + zd)
#define OWN_ACC(pc) do { _Pragma("unroll") for (int d0 = 0; d0 < 4; ++d0) _Pragma("unroll") for (int g = 0; g < 4; g += 2) { u32x2v wa, wb; unpair16(pc[2 * d0 + g / 2], wa, wb); \
        oT[d0][4 * g] += bf_lo(wa.x); oT[d0][4 * g + 1] += bf_hi(wa.x); oT[d0][4 * g + 2] += bf_lo(wa.y); oT[d0][4 * g + 3] += bf_hi(wa.y); \
        oT[d0][4 * g + 4] += bf_lo(wb.x); oT[d0][4 * g + 5] += bf_hi(wb.x); oT[d0][4 * g + 6] += bf_lo(wb.y); oT[d0][4 * g + 7] += bf_hi(wb.y); } } while (0)
    if (nsel > 2) {
        const bool k0 = OWN_KEEP(0), k1 = OWN_KEEP(1), k2 = OWN_KEEP(2);
        v4u pa[8], pb[8], pc[8]; rows_gather_issue(pa, PO0 + m * DM + h * HD, k0 ? 1 : 0, lane); rows_gather_issue(pb, PO1 + m * DM + h * HD, k1 ? 1 : 0, lane); rows_gather_issue(pc, PO2 + m * DM + h * HD, k2 ? 1 : 0, lane);
        if (k0) lsel += LS[(m * NH + h) * 4 + 0];
        if (k1) lsel += LS[(m * NH + h) * 4 + 1];
        if (k2) lsel += LS[(m * NH + h) * 4 + 2];
        rows_gather_finish(pa, lane); OWN_ACC(pa); rows_gather_finish(pb, lane); OWN_ACC(pb); rows_gather_finish(pc, lane); OWN_ACC(pc);
    } else if (nsel == 2) {
        const bool k0 = OWN_KEEP(0), k1 = OWN_KEEP(1);
        v4u pa[8], pb[8]; rows_gather_issue(pa, PO0 + m * DM + h * HD, k0 ? 1 : 0, lane); rows_gather_issue(pb, PO1 + m * DM + h * HD, k1 ? 1 : 0, lane);
        if (k0) lsel += LS[(m * NH + h) * 4 + 0];
        if (k1) lsel += LS[(m * NH + h) * 4 + 1];
        rows_gather_finish(pa, lane); OWN_ACC(pa); rows_gather_finish(pb, lane); OWN_ACC(pb);
    } else if (nsel == 1) {
        const bool k0 = OWN_KEEP(0);
        v4u pa[8]; rows_gather_issue(pa, PO0 + m * DM + h * HD, k0 ? 1 : 0, lane);
        if (k0) lsel += LS[(m * NH + h) * 4 + 0];
        rows_gather_finish(pa, lane); OWN_ACC(pa);
    }
#undef OWN_KEEP
#undef OWN_ACC
    bf16x8 qr[8];
    { v4u qv[8]; rows_gather_issue(qv, Q + m * DM + h * HD, 1, lane);
      Stg kv[4]; block_stage_issue(kv, K, V, krow0, h * HD, tid);
      rows_gather_finish(qv, lane);
#pragma unroll
      for (int d0 = 0; d0 < 8; ++d0) qr[d0] = __builtin_bit_cast(bf16x8, qv[d0]);
      block_stage_finish(kv, lds, tid); }
    float lsum = 0.f;
    int qin = wid * 32 + r32; asm volatile("" : "+v"(qin));
    block_tiles<true>(oT, lsum, qr, qin, qin, (wid >> 1) + 1, sl2, mref2, lds, r32, hi, lane);
    lsum += __shfl_xor(lsum, 32);
    lsum += lsel;
    const float rl = 1.0f / lsum;
    { v4u pc[8];
#pragma unroll
      for (int d0 = 0; d0 < 4; ++d0)
#pragma unroll
          for (int g = 0; g < 4; g += 2) { u32x2v wa, wb; wa.x = cvtpk(oT[d0][4 * g] * rl, oT[d0][4 * g + 1] * rl); wa.y = cvtpk(oT[d0][4 * g + 2] * rl, oT[d0][4 * g + 3] * rl);
              wb.x = cvtpk(oT[d0][4 * g + 4] * rl, oT[d0][4 * g + 5] * rl); wb.y = cvtpk(oT[d0][4 * g + 6] * rl, oT[d0][4 * g + 7] * rl);
              pc[2 * d0 + g / 2] = pair16(wa, wb); }
      rows_scatter(pc, AO + m * DM + h * HD, do_store ? 1 : 0, lane); }
    __syncthreads();
}
}

struct Args { const float* in[15]; float* out; unsigned char* ws; int pad0, pad1; };
__global__ void __launch_bounds__(NWAVES * 64, 2) fwd(Args args) {
    extern __shared__ __attribute__((aligned(16))) unsigned char lds_raw[];
    LAS unsigned char* lds = (LAS unsigned char*)lds_raw;
    volatile LAS unsigned* MISC = (volatile LAS unsigned*)(lds + MISC_OFF);
    const int tid = threadIdx.x, lane = tid & 63, wave = __builtin_amdgcn_readfirstlane(tid >> 6);
    const int G = gridDim.x, bx = blockIdx.x;
    const int vcu = (G % 8 == 0) ? (bx % 8) * (G / 8) + bx / 8 : bx;
    const int gw = vcu * NWAVES + wave, NGW = G * NWAVES;
    unsigned char* ws = args.ws;
    gu32* ctl = (gu32*)(ws + WS_CTL);
    const float* x = args.in[0]; const float* mix_norm = args.in[1]; const float* ffn_norm = args.in[2]; const float* w_in = args.in[3]; const float* conv_w = args.in[4];
    const float* sgu_gain = args.in[5]; const float* w_s = args.in[6]; const float* b_s = args.in[7]; const float* w_mix_out = args.in[8]; const float* w_qkv = args.in[9];
    const float* q_gain = args.in[10]; const float* k_gain = args.in[11]; const float* w_attn_out = args.in[12]; const float* w_up = args.in[13]; const float* w_down = args.in[14];
    float* out = args.out;
    bf16* WIN = (bf16*)(ws + WS_WIN); bf16* WOUT = (bf16*)(ws + WS_WOUT); bf16* WUP0 = (bf16*)(ws + WS_WUP0); bf16* WDN0 = (bf16*)(ws + WS_WDN0);
    bf16* WQKV = (bf16*)(ws + WS_WQKV); bf16* WO = (bf16*)(ws + WS_WO); bf16* WUP1 = (bf16*)(ws + WS_WUP1); bf16* WDN1 = (bf16*)(ws + WS_WDN1);
    bf16* XB = (bf16*)(ws + WS_HB); bf16* Z = (bf16*)(ws + WS_Z); bf16* CAT = (bf16*)(ws + WS_CAT); bf16* HID = (bf16*)(ws + WS_HID);
    bf16* QB = (bf16*)(ws + WS_Q); bf16* KB = (bf16*)(ws + WS_K); bf16* VB = (bf16*)(ws + WS_V);
    bf16* PO0 = (bf16*)(ws + WS_PO0); bf16* PO1 = (bf16*)(ws + WS_PO1); bf16* PO2 = (bf16*)out;
    bf16* WSB = (bf16*)(ws + WS_WSB); float* KMP = (float*)(ws + WS_KMP); unsigned* SEL = (unsigned*)(ws + WS_SEL); float* LS = (float*)(ws + WS_LS); float* RSS = (float*)(ws + WS_RSS);
    LAS float* RINV = (LAS float*)(lds + RINV_OFF);
    signed char* XQ = (signed char*)(ws + WS_XQ); signed char* WQ0 = (signed char*)(ws + WS_WUP0); signed char* WQ1 = (signed char*)(ws + WS_WUP1); float* ROWS = (float*)(ws + WS_ROWS); unsigned* CMAX = (unsigned*)(ws + WS_CMAX); unsigned* CMAXIN = (unsigned*)(ws + WS_CMAX_IN); unsigned* CMAXO = (unsigned*)(ws + WS_CMAX_O); unsigned* CMAXQ = (unsigned*)(ws + WS_CMAX_QKV); signed char* WQQ = (signed char*)(ws + WS_WQKV); signed char* WQO = (signed char*)(ws + WS_WO); signed char* WQIN = (signed char*)(ws + WS_WQKV + 12 * MiB); unsigned* CMAXD = (unsigned*)(ws + WS_CMAX_DN); int* CSUMD = (int*)(ws + WS_CSUM_DN); signed char* WQD0 = (signed char*)(ws + WS_WDN0); signed char* WQD1 = (signed char*)(ws + WS_WDN1); float* HROWS = (float*)(ws + WS_HROWS);

    for (int u = tid; u < (LDS_BYTES - LDSCTL_OFF) / 4; u += NWAVES * 64) ((LAS unsigned*)(lds + LDSCTL_OFF))[u] = 0u;
    __syncthreads();
    const XcdBarrier bar = xcd_barrier_post((unsigned*)(ctl + CW_BAR), MISC + 8);
#ifndef REPEAT_MASK
#define REPEAT_MASK 0
#endif
#define PH(k) for (int rep_ = 0; rep_ < 1 + (((REPEAT_MASK) >> (k)) & 1); ++rep_)
#define NORM_ORDER(S, N_) pg8::NormOrder S; S.init(M, N_, G, bx); S.rss = RSS; S.tab = RINV; S.inv_n = 1.0f / DM; S.eps = EPS

    PH(0) {
        LAS unsigned char* scr = lds + RING_OFF + wave * 16384;
        constexpr int I_IN = (DM / 64) * (NMIX / 64), I_SQ = (DM / 64) * (DM / 64), I_UP = (DM / 64) * (DFF / 64), I_DN = (DFF / 64) * (DM / 64), I_QKV = (DM / 64) * (NQKV / 64);
        constexpr int I_UV = (DM / 64) * (2 * CW / 64); constexpr int NITEMS = I_IN + 2 * I_SQ + 2 * I_UP + 2 * I_DN + I_QKV + I_UV;
        for (int it = gw; it < NITEMS; it += NGW) {
            int r = it;
            if (r < I_IN) { p0_transpose_item(w_in, DM, NMIX, WIN, scr, r, lane, mix_norm); continue; } r -= I_IN;
            if (r < I_SQ) { p0_transpose_item(w_mix_out, DM, DM, WOUT, scr, r, lane, nullptr); continue; } r -= I_SQ;
            if (r < I_UP) { up_absmax_item(w_up, DM, DFF, CMAX, r, lane, ffn_norm); continue; } r -= I_UP;
            if (r < I_DN) { up_absmax_item(w_down, DFF, DM, CMAXD, r, lane, nullptr); continue; } r -= I_DN;
            if (r < I_QKV) { up_absmax_item(w_qkv, DM, NQKV, CMAXQ, r, lane, mix_norm + DM); continue; } r -= I_QKV;
            if (r < I_SQ) { up_absmax_item(w_attn_out, DM, DM, CMAXO, r, lane, nullptr); continue; } r -= I_SQ;
            if (r < I_UP) { up_absmax_item(w_up + (size_t)DM * DFF, DM, DFF, CMAX + DFF, r, lane, ffn_norm + DM); continue; } r -= I_UP;
            if (r < I_DN) { up_absmax_item(w_down + (size_t)DFF * DM, DFF, DM, CMAXD + DM, r, lane, nullptr); continue; } r -= I_DN;
            up_absmax_item(w_in + 3 * CW, DM, 2 * CW, CMAXIN, r, lane, mix_norm, NMIX);
        }
        for (int e = (bx * NWAVES * 64 + tid) * 4; e < SGG * 128 * 128; e += G * NWAVES * 64 * 4) {
            const int i = (e >> 7) & 127, j = e & 127; const f32x4 v = *(const GAS f32x4*)(w_s + e);
            u32x2v w; w.x = pk2(j <= i ? v.x : 0.f, j + 1 <= i ? v.y : 0.f); w.y = pk2(j + 2 <= i ? v.z : 0.f, j + 3 <= i ? v.w : 0.f);
            *(GAS u32x2v*)(WSB + e) = w;
        }
        xb_rows(x, XB, RSS, XQ, ROWS, gw, NGW, lane);
    }
    xcd_barrier(bar);
    {
        LAS unsigned char* scr = lds + RING_OFF + wave * 16384;
        constexpr int I_INQ = (DM / 64) * (NMIX / 64);
        constexpr int I_UVQ = (DM / 64) * (2 * CW / 64);
        for (int it = gw; it < I_UVQ; it += NGW) up_quant_item(w_in + 3 * CW, DM, 2 * CW, WQIN, (const float*)CMAXIN, scr, it, lane, mix_norm, nullptr, NMIX);
        constexpr int I_DQ = (DFF / 64) * (DM / 64);
        for (int it = gw; it < 2 * I_DQ; it += NGW) { const int l = it >= I_DQ ? 1 : 0;
            up_quant_item(w_down + (size_t)l * DFF * DM, DFF, DM, l ? WQD1 : WQD0, (const float*)CMAXD + l * DM, scr, it - l * I_DQ, lane, nullptr, CSUMD + l * DM); }
        constexpr int I_QQ = (DM / 64) * (NQKV / 64);
        for (int it = gw; it < I_QQ; it += NGW) up_quant_item(w_qkv, DM, NQKV, WQQ, (const float*)CMAXQ, scr, it, lane, mix_norm + DM);
        constexpr int I_OQ = (DM / 64) * (DM / 64);
        for (int it = gw; it < I_OQ; it += NGW) up_quant_item(w_attn_out, DM, DM, WQO, (const float*)CMAXO, scr, it, lane, nullptr);
    }
    xcd_barrier(bar);
    PH(1) {
        { pg8::Gemm g{XB, WIN, M, 3 * CW, DM}; NORM_ORDER(S, 3 * CW);
          pg8::EpiActR<1> E{Z, NMIX, 0, 0, RINV, 1 << 20};
          pg8::gemm_phase<pg8::EpiActR<1>, pg8::NormOrder, PG8_ALIGN, PG8_SP2>(lds + RING_OFF, g, S, E); }
        { pg8::Gemm g{(const bf16*)XQ, (const bf16*)WQIN, M, 2 * CW, DM / 2};
          pg8::ScaleOrder S; S.init(M, 2 * CW, G, bx); S.rows = ROWS; S.tab = RINV;
          pg8::EpiActR<1, 0, false, true> E{Z + 3 * CW, NMIX, 0, 0, RINV, 0, (const float*)CMAXIN};
          pg8::gemm_phase<pg8::EpiActR<1, 0, false, true>, pg8::ScaleOrder, PG8_ALIGN, PG8_SP2>(lds + RING_OFF, g, S, E); }
    }
    xcd_barrier(bar);
    PH(2) { for (int u = vcu; u < M / SGC; u += G) mixer_unit(u, Z, CAT, conv_w, sgu_gain, WSB, b_s, lds + RING_OFF, tid); }
    xcd_barrier(bar);
    {
        pg8::Gemm g{CAT, WOUT, M, DM, DM}; pg8::StaticOrder S; S.init(M, DM, G, bx);
        pg8::EpiResB<false> E{XB, DM, nullptr, 0, RSS};
        pg8::gemm_phase<pg8::EpiResB<false>, pg8::StaticOrder, PG8_ALIGN, PG8_SP2>(lds + RING_OFF, g, S, E);
    }
    xcd_barrier(bar);
    {
        LAS unsigned char* scr = lds + RING_OFF + wave * 16384;
        constexpr int I_UPQ = (DM / 64) * (DFF / 64);
        for (int it = gw; it < 2 * I_UPQ; it += NGW) { const int l = it >= I_UPQ ? 1 : 0;
            up_quant_item(w_up + (size_t)l * DM * DFF, DM, DFF, l ? WQ1 : WQ0, (const float*)CMAX + l * DFF, scr, it - l * I_UPQ, lane, ffn_norm + l * DM); }
        xq_rows<true>(XB, XQ, ROWS, gw, NGW, lane);
    }
    xcd_barrier(bar);
    {
        pg8::Gemm g{(const bf16*)XQ, (const bf16*)WQ0, M, DFF, DM / 2};
        pg8::ScaleOrder S; S.init(M, DFF, G, bx); S.rows = ROWS; S.tab = RINV;
        pg8::EpiActR<2, 0, true, true> E{HID, DFF, 0, 0, RINV, 0, (const float*)CMAX};
        pg8::gemm_phase<pg8::EpiActR<2, 0, true, true>, pg8::ScaleOrder, PG8_ALIGN, PG8_SP2>(lds + RING_OFF, g, S, E);
    }
    xcd_barrier(bar);
    hq_rows(HID, HROWS, gw, NGW, lane);
    xcd_barrier(bar);
    {
        pg8::Gemm g{HID, (const bf16*)WQD0, M, DM, DFF / 2, 2}; pg8::ScaleOrder S; S.init(M, DM, G, bx); S.rows = HROWS; S.tab = RINV;
        pg8::EpiResB<false, true, true> E{XB, DM, nullptr, 0, RSS, RINV, (const float*)CMAXD, CSUMD};
        pg8::gemm_phase<pg8::EpiResB<false, true, true>, pg8::ScaleOrder, PG8_ALIGN, PG8_SP2>(lds + RING_OFF, g, S, E);
    }
    xcd_barrier(bar);
    xq_rows<true>(XB, XQ, ROWS, gw, NGW, lane);
    xcd_barrier(bar);
    PH(8) {
        pg8::Gemm g{(const bf16*)XQ, (const bf16*)WQQ, M, NQKV, DM / 2};
        pg8::ScaleOrder S; S.init(M, NQKV, G, bx); S.rows = ROWS; S.tab = RINV;
        static_assert(PG8_ALIGN, "EpiQKV contains a workgroup barrier: both half-workgroups must run their epilogues together");
        pg8::EpiQKVT<true> E{QB, DM, (size_t)M * DM, RINV, (LAS float*)(lds + XCH_OFF), q_gain, k_gain, KMP, EPS, NH, NBLK, (const float*)CMAXQ};
        pg8::gemm_phase<pg8::EpiQKVT<true>, pg8::ScaleOrder, PG8_ALIGN, PG8_SP2>(lds + RING_OFF, g, S, E);
    }
    xcd_barrier(bar);
    float mref2;
    { int l2 = lane; asm volatile("" : "+v"(l2));
      const float gqm = wave_max(fmaxf(fabsf(q_gain[l2]), fabsf(q_gain[l2 + 64]))), gkm = wave_max(fmaxf(fabsf(k_gain[l2]), fabsf(k_gain[l2 + 64])));
      mref2 = 11.313708498984761f * gqm * gkm * att::LOG2E; }
    PH(10) { for (int u = bx; u < NB * NH * NBLK; u += G) { const int bh = u % (NB * NH), i = u / (NB * NH); att::gate_unit(bh / NH, bh % NH, i, QB, KMP, SEL, lds + RING_OFF, tid); } }
    xcd_barrier(bar);
    {
        gu32* selq = ctl + CW_SELQ; volatile LAS unsigned* tkw = MISC + 20;
        if (tid == 0) tkw[0] = __hip_atomic_fetch_add(selq, 1u, RLX_AGENT);
        LDS_WAIT(); __syncthreads();
        unsigned tk = tkw[0];
        __syncthreads();
        while (tk < (unsigned)(NB * NH * NBLK)) {
            unsigned nxt = 0u;
            if (tid == 0) nxt = __hip_atomic_fetch_add(selq, 1u, RLX_AGENT);
            const int j = (int)(tk / (NB * NH)), hb = (int)(tk % (NB * NH)), b = hb & 1, h = (NH - 1) - (hb >> 1);
            const float sl2 = __builtin_amdgcn_exp2f(-0.5f * (float)(h + 1)) * att::LOG2E;
            att::sel_unit(b, h, j, QB, KB, VB, SEL, PO0, PO1, PO2, LS, sl2, mref2, lds + RING_OFF, tid);
            if (tid == 0) tkw[0] = nxt;
            LDS_WAIT(); __syncthreads();
            tk = tkw[0];
            __syncthreads();
        }
    }
    xcd_barrier(bar);
    {
        for (int u = bx; u < NB * NH * NBLK; u += G) { const int bh = u % (NB * NH), i = u / (NB * NH); const int h = bh % NH; const float sl2 = __builtin_amdgcn_exp2f(-0.5f * (float)(h + 1)) * att::LOG2E;
            att::own_unit(bh / NH, h, i, QB, KB, VB, PO0, PO1, PO2, LS, SEL, QB, sl2, mref2, lds + RING_OFF, tid); }
    }
    xcd_barrier(bar);
    xq_rows<false>(QB, XQ, ROWS, gw, NGW, lane);
    xcd_barrier(bar);
    {
        pg8::Gemm g{(const bf16*)XQ, (const bf16*)WQO, M, DM, DM / 2};
        pg8::ScaleOrder S; S.init(M, DM, G, bx); S.rows = ROWS; S.tab = RINV;
        pg8::EpiResB<false, true> E{XB, DM, nullptr, 0, RSS, RINV, (const float*)CMAXO};
        pg8::gemm_phase<pg8::EpiResB<false, true>, pg8::ScaleOrder, PG8_ALIGN, PG8_SP2>(lds + RING_OFF, g, S, E);
    }
    xcd_barrier(bar);
    xq_rows<true>(XB, XQ, ROWS, gw, NGW, lane);
    xcd_barrier(bar);
    {
        pg8::Gemm g{(const bf16*)XQ, (const bf16*)WQ1, M, DFF, DM / 2};
        pg8::ScaleOrder S; S.init(M, DFF, G, bx); S.rows = ROWS; S.tab = RINV;
        pg8::EpiActR<2, 0, true, true> E{HID, DFF, 0, 0, RINV, 0, (const float*)CMAX + DFF};
        pg8::gemm_phase<pg8::EpiActR<2, 0, true, true>, pg8::ScaleOrder, PG8_ALIGN, PG8_SP2>(lds + RING_OFF, g, S, E);
    }
    xcd_barrier(bar);
    hq_rows(HID, HROWS, gw, NGW, lane);
    xcd_barrier(bar);
    {
        pg8::Gemm g{HID, (const bf16*)WQD1, M, DM, DFF / 2, 2}; pg8::ScaleOrder S; S.init(M, DM, G, bx); S.rows = HROWS; S.tab = RINV;
        pg8::EpiResB<true, true, true> E{XB, DM, out, DM, nullptr, RINV, (const float*)CMAXD + DM, CSUMD + DM};
        pg8::gemm_phase<pg8::EpiResB<true, true, true>, pg8::ScaleOrder, PG8_ALIGN, PG8_SP2>(lds + RING_OFF, g, S, E);
    }
#undef PH
#undef NORM_ORDER
}

extern "C" void kernel_launch(void* const* d_in, const int* in_sizes, int n_in, void* d_out, int out_size, void* d_ws, size_t ws_size, hipStream_t stream) {
    static int grid = 0;
    if (grid == 0) {
        if (n_in != 15 || in_sizes[0] != M * DM || out_size != M * DM || ws_size < WS_END) {
            fprintf(stderr, "kernel_launch: built for 15 inputs, x/out of %d floats, >= %zu bytes of workspace; got n_in %d, in0 %d, out %d, ws %zu; nothing launched\n", M * DM, (size_t)WS_END, n_in, n_in > 0 ? in_sizes[0] : -1, out_size, ws_size);
            grid = -1; return; }
        int dev = 0, cus = 0, per_cu = 0;
        if (hipGetDevice(&dev) != hipSuccess || hipDeviceGetAttribute(&cus, hipDeviceAttributeMultiprocessorCount, dev) != hipSuccess) { fprintf(stderr, "kernel_launch: device query failed\n"); grid = -1; return; }
        if (hipFuncSetAttribute((const void*)fwd, hipFuncAttributeMaxDynamicSharedMemorySize, LDS_BYTES) != hipSuccess) { fprintf(stderr, "kernel_launch: hipFuncSetAttribute failed\n"); grid = -1; return; }
        if (hipOccupancyMaxActiveBlocksPerMultiprocessor(&per_cu, (const void*)fwd, NWAVES * 64, LDS_BYTES) != hipSuccess || per_cu < 1)
            fprintf(stderr, "kernel_launch: note: occupancy query reports %d workgroups per CU\n", per_cu);
        (void)hipGetLastError();
        grid = cus;
    }
    if (grid < 0) return;
    if (hipMemsetAsync((char*)d_ws + WS_CTL, 0, CTL_ZERO_BYTES, stream) != hipSuccess) { fprintf(stderr, "kernel_launch: memset failed\n"); return; }
    Args a{};
    for (int i = 0; i < 15; ++i) a.in[i] = (const float*)d_in[i];
    a.out = (float*)d_out; a.ws = (unsigned char*)d_ws;
    hipLaunchKernelGGL(fwd, dim3(grid), dim3(NWAVES * 64), LDS_BYTES, stream, a);
    const hipError_t le = hipPeekAtLastError();
    if (le != hipSuccess) fprintf(stderr, "kernel_launch: launch failed: %s\n", hipGetErrorName(le));
}
```

```cpp
#include <hip/hip_runtime.h>
#include <cstdio>
#include <cstdint>

namespace pg8 {
#define PG8_LAS __attribute__((address_space(3)))
typedef unsigned short bf16_t;
typedef short bf16x8 __attribute__((ext_vector_type(8)));
typedef float f32x4 __attribute__((ext_vector_type(4)));
typedef unsigned u32x4 __attribute__((ext_vector_type(4)));
typedef int i32x4 __attribute__((ext_vector_type(4)));
constexpr int BM = 256, BK = 64, HALF = 128, HTB = HALF * BK * 2  , STAGE_BYTES = 8 * HTB, NXCD = 8, WGM = 4;

__host__ __device__ __forceinline__ int lds_byte(int r, int c) { const int st = (r >> 4) * 2 + (c >> 5), rr = r & 15, cc = c & 31, ob = rr * 64 + cc * 2; return st * 1024 + (ob ^ (((ob >> 9) & 1) << 5)); }
__host__ __device__ __forceinline__ void stage_rc(int b, int& R, int& C) { const int st = b / 1024, sb = b % 1024, swz = sb ^ (((sb >> 9) & 1) << 5); R = (st >> 1) * 16 + swz / 64; C = (st & 1) * 32 + (swz % 64) / 2; }
__host__ __device__ __forceinline__ int perm32(int rho) { const int n = rho >> 4, i = rho & 15; return 8 * (i >> 2) + 4 * n + (i & 3); }

struct Unit { int pm, pn, idx; };
struct Gemm { const bf16_t* A; const bf16_t* Bt; int M, N, K; int a_tiled; };

struct StaticOrder {
    int nM, nN, nwg, G, c, i0, ilim;
    __host__ __device__ void init(int M, int N, int G_, int c_) { nM = M / BM; nN = N / BM; nwg = nM * nN; G = G_; c = c_; i0 = 0; ilim = 1 << 30; }
    __host__ __device__ bool next(int i, Unit& u) const {
        if (i >= ilim) return false;
        const long L = (long)(i + i0) * G + c; if (L >= nwg) return false;
        int wgid = (int)L; { const int q = nwg / NXCD, r = nwg % NXCD, xcd = wgid % NXCD, off = wgid / NXCD; wgid = (xcd < r ? xcd * (q + 1) : r * (q + 1) + (xcd - r) * q) + off; }
        const int nig = WGM * nN, gid = wgid / nig, fm = gid * WGM, gsz = (nM - fm) < WGM ? (nM - fm) : WGM;
        u.pm = fm + ((wgid % nig) % gsz); u.pn = (wgid % nig) / gsz; u.idx = i; return true;
    }
    __device__ __forceinline__ void a_ready(const Unit&) const {}
    __device__ __forceinline__ void done(const Unit&) const {}
    __device__ __forceinline__ void after_epi(const Unit&) const {}
};

__device__ __forceinline__ unsigned cvt_pk_bf16(float lo, float hi) { unsigned r; asm volatile("v_cvt_pk_bf16_f32 %0, %1, %2" : "=v"(r) : "v"(lo), "v"(hi)); return r; }
typedef float f32x2 __attribute__((ext_vector_type(2)));
__device__ __forceinline__ f32x2 gelu_pk(f32x2 v) {
    const f32x2 av = __builtin_elementwise_abs(v), d = av * 0.2316418882f + 1.0f;
    f32x2 t; t.x = __builtin_amdgcn_rcpf(d.x); t.y = __builtin_amdgcn_rcpf(d.y);
    f32x2 q = t * 0.5307027145f + (-0.7265760135f); q = q * t + 0.7107068705f; q = q * t + (-0.142248368f); q = q * t + 0.127414796f; q = q * t;
    const f32x2 s = (v * v) * (-0.72134752044f);
    f32x2 e; e.x = __builtin_amdgcn_exp2f(s.x); e.y = __builtin_amdgcn_exp2f(s.y);
    const f32x2 m = v * (q * e), r = v - m;
    f32x2 o; o.x = v.x < 0.f ? m.x : r.x; o.y = v.y < 0.f ? m.y : r.y; return o;
}

template <class Epi, class Sched, bool ALIGN_EPI = false, bool SP2 = false>
__device__ __forceinline__ void gemm_phase(PG8_LAS unsigned char* lds, const Gemm g, const Sched& S, const Epi& E) {
    int tid_ = threadIdx.x; asm volatile("" : "+v"(tid_));
    const int tid = tid_, wid = __builtin_amdgcn_readfirstlane(tid >> 6), lane = tid & 63, wr = wid >> 2, wc = wid & 3, fr = lane & 15, fq = lane >> 4;
    const int K = g.K, nt = K / BK;
    const int lda = g.a_tiled ? BM : K;
    unsigned voffA[2], voffB[2];
#pragma unroll
    for (int i = 0; i < 2; ++i) { int R, C; stage_rc(tid * 16 + i * 8192, R, C); const int Rb = Epi::PERM ? (64 * (R >> 5) + perm32(R & 31)) : R;
        voffA[i] = (unsigned)(R * lda + C) * 2u; voffB[i] = (unsigned)(Rb * K + C) * 2u; }
    const size_t kstep = (size_t)(BK * 2);
    const size_t hstepA = (size_t)HALF * lda * 2;
    const size_t hstepB = Epi::PERM ? (size_t)32 * K * 2 : hstepA;
    const size_t tstep = (size_t)BM * K * 2;
    const size_t tstepA = g.a_tiled == 2 ? (size_t)BM * K * 4 : tstep;
    const unsigned ldsw = (unsigned)wid * 1024u;
    const int aoff = lds_byte(wr * 64 + fr, fq * 8), boff = lds_byte(wc * 32 + fr, fq * 8);
#define PG8_SA(b, h) (((b) * 2 + (h)) * HTB)
#define PG8_SB(b, h) ((4 + (b) * 2 + (h)) * HTB)
#define PG8_STAGE(bufoff, gbase, voff) do { _Pragma("unroll") for (int _i = 0; _i < 2; ++_i) \
        __builtin_amdgcn_global_load_lds((const unsigned*)((const char*)(gbase) + (voff)[_i]), (PG8_LAS unsigned*)(lds + (bufoff) + ldsw + _i * 8192), 16, 0, 0); } while (0)
#define PG8_LDA(dst, b, h) do { _Pragma("unroll") for (int m = 0; m < 4; ++m) _Pragma("unroll") for (int k = 0; k < 2; ++k) dst[m][k] = *(const PG8_LAS bf16x8*)(lds + PG8_SA(b, h) + aoff + m * 2048 + k * 1024); } while (0)
#define PG8_LDB(dst, b, h) do { _Pragma("unroll") for (int n = 0; n < 2; ++n) _Pragma("unroll") for (int k = 0; k < 2; ++k) dst[n][k] = *(const PG8_LAS bf16x8*)(lds + PG8_SB(b, h) + boff + n * 2048 + k * 1024); } while (0)
#define PG8_MMA(ai, bj, At, Bt) do { __builtin_amdgcn_s_setprio(1); _Pragma("unroll") for (int m = 0; m < 4; ++m) _Pragma("unroll") for (int n = 0; n < 2; ++n) _Pragma("unroll") for (int k = 0; k < 2; ++k) { \
        if constexpr (Epi::I8) acc[ai][bj][m][n] = __builtin_bit_cast(f32x4, __builtin_amdgcn_mfma_i32_16x16x64_i8(__builtin_bit_cast(i32x4, Bt[n][k]), __builtin_bit_cast(i32x4, At[m][k]), __builtin_bit_cast(i32x4, acc[ai][bj][m][n]), 0, 0, 0)); \
        else acc[ai][bj][m][n] = __builtin_amdgcn_mfma_f32_16x16x32_bf16(Bt[n][k], At[m][k], acc[ai][bj][m][n], 0, 0, 0); } __builtin_amdgcn_s_setprio(0); } while (0)
#define PG8_WAIT_V(n) asm volatile("s_waitcnt vmcnt(" #n ")" ::: "memory")
#define PG8_WAIT_L(n) asm volatile("s_waitcnt lgkmcnt(" #n ")" ::: "memory")
#define PG8_BAR __builtin_amdgcn_s_barrier()
#define PG8_SCHED __builtin_amdgcn_sched_barrier(0)
    Unit cur, nxt; int ui = 0;
    if (!S.next(0, cur)) return;
    f32x4 acc[2][2][4][2];
#pragma unroll
    for (int a = 0; a < 2; ++a)
#pragma unroll
        for (int b = 0; b < 2; ++b)
#pragma unroll
            for (int m = 0; m < 4; ++m)
#pragma unroll
                for (int n = 0; n < 2; ++n) acc[a][b][m][n] = (f32x4){0.f, 0.f, 0.f, 0.f};
    bf16x8 At[4][2], B0[2][2], B1[2][2];
    const char* cA = (const char*)g.A + (size_t)cur.pm * tstepA; const char* cB = (const char*)g.Bt + (size_t)cur.pn * tstep;
    S.a_ready(cur);
    if constexpr (SP2) {
        PG8_STAGE(PG8_SB(0, 0), cB, voffB); PG8_STAGE(PG8_SB(0, 1), cB + hstepB, voffB); PG8_STAGE(PG8_SA(0, 0), cA, voffA); PG8_STAGE(PG8_SA(0, 1), cA + hstepA, voffA);
        if (wr == 1) PG8_BAR;
        PG8_WAIT_V(2); PG8_BAR;
        PG8_STAGE(PG8_SB(1, 0), cB + kstep, voffB); PG8_STAGE(PG8_SA(1, 0), cA + kstep, voffA); PG8_STAGE(PG8_SB(1, 1), cB + hstepB + kstep, voffB);
        PG8_WAIT_V(6); PG8_BAR;
    } else {
        PG8_STAGE(PG8_SB(0, 0), cB, voffB); PG8_STAGE(PG8_SA(0, 0), cA, voffA); PG8_STAGE(PG8_SB(0, 1), cB + hstepB, voffB); PG8_STAGE(PG8_SA(0, 1), cA + hstepA, voffA);
        if (wr == 1) PG8_BAR;
        PG8_WAIT_V(4); PG8_BAR;
        PG8_STAGE(PG8_SB(1, 0), cB + kstep, voffB); PG8_STAGE(PG8_SA(1, 0), cA + kstep, voffA); PG8_STAGE(PG8_SB(1, 1), cB + hstepB + kstep, voffB);
        PG8_WAIT_V(6); PG8_BAR;
    }
    for (;;) {
        const bool has_next = S.next(ui + 1, nxt);
        const char* nA = has_next ? (const char*)g.A + (size_t)nxt.pm * tstepA : cA; const char* nB = has_next ? (const char*)g.Bt + (size_t)nxt.pn * tstep : cB;
        for (int t = 0; t < nt; t += 2) {
            const bool last = (t == nt - 2);
            const size_t ka = g.a_tiled == 2 ? ((size_t)(t >> 1) << 17) : g.a_tiled ? (((size_t)(t >> 2) << 17) + (size_t)((t & 2) << 7)) : (size_t)t * kstep, ka2 = g.a_tiled == 2 ? ((size_t)((t + 2) >> 1) << 17) : g.a_tiled ? (((size_t)((t + 2) >> 2) << 17) + (size_t)(((t + 2) & 2) << 7)) : (size_t)(t + 2) * kstep;
            const char* a1 = cA + ka + kstep;
            const char* a2 = last ? nA : cA + ka2; const char* b2 = last ? nB : cB + (size_t)(t + 2) * kstep;
            const char* a3 = a2 + kstep; const char* b3 = b2 + kstep;
            if (last && has_next) S.a_ready(nxt);
            if constexpr (SP2) {
            PG8_LDB(B0, 0, 0); PG8_LDB(B1, 0, 1); PG8_SCHED; PG8_LDA(At, 0, 0); PG8_STAGE(PG8_SA(1, 1), a1 + hstepA, voffA);
            PG8_WAIT_V(8); PG8_WAIT_L(0); PG8_BAR; PG8_MMA(0, 0, At, B0); PG8_MMA(0, 1, At, B1); PG8_BAR; PG8_SCHED;
            PG8_LDA(At, 0, 1); PG8_STAGE(PG8_SB(0, 0), b2, voffB); PG8_STAGE(PG8_SB(0, 1), b2 + hstepB, voffB); PG8_STAGE(PG8_SA(0, 0), a2, voffA);
            PG8_WAIT_V(8); PG8_WAIT_L(0); PG8_BAR; PG8_MMA(1, 0, At, B0); PG8_MMA(1, 1, At, B1); PG8_BAR; PG8_SCHED;
            PG8_LDB(B0, 1, 0); PG8_LDB(B1, 1, 1); PG8_SCHED; PG8_LDA(At, 1, 0); PG8_STAGE(PG8_SA(0, 1), a2 + hstepA, voffA);
            PG8_WAIT_V(8); PG8_WAIT_L(0); PG8_BAR; PG8_MMA(0, 0, At, B0); PG8_MMA(0, 1, At, B1); PG8_BAR; PG8_SCHED;
            PG8_LDA(At, 1, 1); PG8_STAGE(PG8_SB(1, 0), b3, voffB); PG8_STAGE(PG8_SB(1, 1), b3 + hstepB, voffB); PG8_STAGE(PG8_SA(1, 0), a3, voffA);
            PG8_WAIT_V(8); PG8_WAIT_L(0); PG8_BAR; PG8_MMA(1, 0, At, B0); PG8_MMA(1, 1, At, B1); PG8_BAR; PG8_SCHED;
            } else {
            PG8_LDB(B0, 0, 0); PG8_SCHED; PG8_LDA(At, 0, 0); PG8_STAGE(PG8_SA(1, 1), a1 + hstepA, voffA);
            PG8_WAIT_L(8); PG8_BAR; PG8_WAIT_L(0); PG8_MMA(0, 0, At, B0); PG8_BAR; PG8_SCHED;
            PG8_LDB(B1, 0, 1); PG8_STAGE(PG8_SB(0, 0), b2, voffB);
            PG8_BAR; PG8_WAIT_L(0); PG8_MMA(0, 1, At, B1); PG8_BAR;
            PG8_LDA(At, 0, 1); PG8_STAGE(PG8_SA(0, 0), a2, voffA);
            PG8_BAR; PG8_WAIT_L(0); PG8_MMA(1, 0, At, B0); PG8_BAR; PG8_SCHED;
            PG8_STAGE(PG8_SB(0, 1), b2 + hstepB, voffB);
            PG8_WAIT_V(6); PG8_BAR; PG8_MMA(1, 1, At, B1); PG8_BAR;
            PG8_LDB(B0, 1, 0); PG8_SCHED; PG8_LDA(At, 1, 0); PG8_STAGE(PG8_SA(0, 1), a2 + hstepA, voffA);
            PG8_WAIT_L(8); PG8_BAR; PG8_WAIT_L(0); PG8_MMA(0, 0, At, B0); PG8_BAR; PG8_SCHED;
            PG8_LDB(B1, 1, 1); PG8_STAGE(PG8_SB(1, 0), b3, voffB);
            PG8_BAR; PG8_WAIT_L(0); PG8_MMA(0, 1, At, B1); PG8_BAR;
            PG8_LDA(At, 1, 1); PG8_STAGE(PG8_SA(1, 0), a3, voffA);
            PG8_BAR; PG8_WAIT_L(0); PG8_MMA(1, 0, At, B0); PG8_BAR; PG8_SCHED;
            PG8_STAGE(PG8_SB(1, 1), b3 + hstepB, voffB);
            PG8_WAIT_V(6); PG8_BAR; PG8_MMA(1, 1, At, B1); PG8_BAR;
            }
        }
        if constexpr (ALIGN_EPI) { if (wr == 0) PG8_BAR; }
        if constexpr (!Epi::AFTER_DRAIN) { E(acc, cur, wr, wc, fr, fq); S.done(cur); if (has_next) S.after_epi(nxt); }
        if (!has_next) break;
#pragma unroll
        for (int a = 0; a < 2; ++a)
#pragma unroll
            for (int b = 0; b < 2; ++b)
#pragma unroll
                for (int m = 0; m < 4; ++m)
#pragma unroll
                    for (int n = 0; n < 2; ++n) acc[a][b][m][n] = (f32x4){0.f, 0.f, 0.f, 0.f};
        cur = nxt; cA = nA; cB = nB; ++ui;
        if constexpr (ALIGN_EPI) { if (wr == 1) PG8_BAR; }
    }
    PG8_WAIT_V(0);
    if constexpr (!ALIGN_EPI) { if (wr == 0) PG8_BAR; }
    PG8_BAR;
    if constexpr (Epi::AFTER_DRAIN) { E.fused(acc, cur, wr, wc, fr, fq, lds, wid, lane); S.done(cur); }
#undef PG8_SA
#undef PG8_SB
#undef PG8_STAGE
#undef PG8_LDA
#undef PG8_LDB
#undef PG8_MMA
#undef PG8_WAIT_V
#undef PG8_WAIT_L
#undef PG8_BAR
#undef PG8_SCHED
}
}

namespace pg8 {
__device__ __forceinline__ float gelu_tanh(float x) {
    const float y = x * (0.7978845608028654f + 0.035677408136300125f * x * x);
    const float e = __builtin_amdgcn_exp2f(y * (-2.0f * 1.4426950408889634f));
    return x * __builtin_amdgcn_rcpf(1.0f + e);
}
constexpr int RSS_PER_ROW = 32;
struct NormOrder : StaticOrder {
    const float* rss; PG8_LAS float* tab; float inv_n, eps;
    __device__ __forceinline__ void a_ready(const Unit& u) const { if (u.idx == 0) table(u); }
    __device__ __forceinline__ void after_epi(const Unit& u) const { table(u); }
    __device__ __forceinline__ void table(const Unit& u) const {
        int t_ = threadIdx.x; asm volatile("" : "+v"(t_));
        const int lane = t_ & 63, wid = __builtin_amdgcn_readfirstlane(t_ >> 6), row = wid * 32 + (lane & 31), half = lane >> 5;
        const f32x4* p = (const f32x4*)(rss + (size_t)(u.pm * BM + row) * RSS_PER_ROW + half * 16);
        float s;
        { const f32x4 a = p[0], b = p[1]; s = ((a[0] + a[1]) + (a[2] + a[3])) + ((b[0] + b[1]) + (b[2] + b[3])); }
        asm volatile("" : "+v"(s));
        { const f32x4 c = p[2], d = p[3]; s += ((c[0] + c[1]) + (c[2] + c[3])) + ((d[0] + d[1]) + (d[2] + d[3])); }
        s += __shfl_xor(s, 32);
        if (half == 0) tab[(u.idx & 1) * BM + row] = 1.0f / sqrtf(s * inv_n + eps);
    }
};
struct ScaleOrder : StaticOrder {
    const float* rows; PG8_LAS float* tab;
    __device__ __forceinline__ void a_ready(const Unit& u) const { if (u.idx == 0) table(u); }
    __device__ __forceinline__ void after_epi(const Unit& u) const { table(u); }
    __device__ __forceinline__ void table(const Unit& u) const {
        int t_ = threadIdx.x; asm volatile("" : "+v"(t_));
        if (t_ < BM) tab[(u.idx & 1) * BM + t_] = rows[(size_t)u.pm * BM + t_];
    }
};
__device__ __forceinline__ unsigned dpp_x1(unsigned v) { return (unsigned)__builtin_amdgcn_update_dpp(0, (int)v, 0xB1, 0xF, 0xF, true); }
__device__ __forceinline__ void pair_lines(u32x4& w0, u32x4& w1, bool odd) {
#pragma unroll
    for (int c = 0; c < 4; ++c) { const unsigned a = w0[c], b = w1[c], na = dpp_x1(a), nb = dpp_x1(b); w0[c] = odd ? nb : a; w1[c] = odd ? b : na; }
}
template <int ACT, int PROBE = 0, bool TILED = false, bool I8_ = false> struct EpiActR {
    static constexpr bool PERM = true, AFTER_DRAIN = false, I8 = I8_;
    bf16_t* O; int ldc; int split_cols; size_t split_stride; const PG8_LAS float* tab; int act_tile0; const float* colmax;
    __device__ __forceinline__ void operator()(const f32x4 (&acc)[2][2][4][2], const Unit& u, int wr, int wc, int fr, int fq) const {
        const int row0 = u.pm * BM + wr * 64 + fr; int colt = u.pn * BM; bf16_t* base = O;
        if (split_cols) { const int t = colt / split_cols; base += (size_t)t * split_stride; colt -= t * split_cols; }
        const bool odd = (fr & 1) != 0;
        const int colx = colt + wc * 64 + 8 * fq + (odd ? 32 : 0);
        const int ldo = TILED ? BM : ldc;
        const unsigned offA = TILED ? (unsigned)(((wr * 64 + fr) & ~1) * BM + wc * 64 + 8 * fq + (odd ? 32 : 0)) * 2u : (unsigned)((row0 & ~1) * ldc + colx) * 2u, offB = offA + (unsigned)ldo * 2u;
        if (TILED) base += (size_t)(u.pm * (ldc / BM) + u.pn) * (BM * BM);
        const PG8_LAS float* tb = tab + (u.idx & 1) * BM + wr * 64 + fr;
        if (PROBE == 2) {
#pragma unroll
            for (int ai = 0; ai < 2; ++ai)
#pragma unroll
                for (int m = 0; m < 4; ++m)
#pragma unroll
                    for (int bj = 0; bj < 2; ++bj) asm volatile("" :: "v"(acc[ai][bj][m][0]), "v"(acc[ai][bj][m][1]));
            return; }
        f32x4 cs[2][2];
        if constexpr (I8) {
#pragma unroll
            for (int bj = 0; bj < 2; ++bj)
#pragma unroll
                for (int n = 0; n < 2; ++n) cs[bj][n] = *(const f32x4*)(colmax + u.pn * BM + wc * 64 + 32 * bj + 8 * fq + 4 * n) * (1.0f / 127.0f); }
#pragma unroll
        for (int ai = 0; ai < 2; ++ai)
#pragma unroll
            for (int m = 0; m < 4; ++m) { const float r = tb[ai * HALF + m * 16];
                u32x4 w[2];
#pragma unroll
                for (int bj = 0; bj < 2; ++bj) { f32x4 v0, v1;
                    if constexpr (I8) { const i32x4 i0 = __builtin_bit_cast(i32x4, acc[ai][bj][m][0]), i1 = __builtin_bit_cast(i32x4, acc[ai][bj][m][1]);
                        v0 = (f32x4){(float)i0[0], (float)i0[1], (float)i0[2], (float)i0[3]} * cs[bj][0] * r; v1 = (f32x4){(float)i1[0], (float)i1[1], (float)i1[2], (float)i1[3]} * cs[bj][1] * r; }
                    else { v0 = acc[ai][bj][m][0] * r; v1 = acc[ai][bj][m][1] * r; }
                    if (ACT == 1) { if (u.pn >= act_tile0) {
#pragma unroll
                        for (int e = 0; e < 4; ++e) { v0[e] = gelu_tanh(v0[e]); v1[e] = gelu_tanh(v1[e]); } } }
                    if (ACT == 2) {
#pragma unroll
                        for (int e = 0; e < 4; ++e) { const float a = fmaxf(v0[e], 0.f), b = fmaxf(v1[e], 0.f); v0[e] = a * a; v1[e] = b * b; } }
                    w[bj].x = cvt_pk_bf16(v0[0], v0[1]); w[bj].y = cvt_pk_bf16(v0[2], v0[3]); w[bj].z = cvt_pk_bf16(v1[0], v1[1]); w[bj].w = cvt_pk_bf16(v1[2], v1[3]); }
                pair_lines(w[0], w[1], odd);
                if (PROBE == 1) asm volatile("" :: "v"(w[0]), "v"(w[1]));
                else { char* pr = (char*)base + (size_t)(ai * HALF + m * 16) * ldo * 2; *(u32x4*)(pr + offA) = w[0]; *(u32x4*)(pr + offB) = w[1]; } }
    }
};
template <bool I8_ = false> struct EpiQKVT {
    static constexpr bool PERM = true, AFTER_DRAIN = false, I8 = I8_;
    bf16_t* O; int ldc; size_t split_stride; const PG8_LAS float* tab; PG8_LAS float* xch; const float* q_gain; const float* k_gain; float* kmp; float eps; int nh, nblk; const float* colmax;
    __device__ __forceinline__ void operator()(f32x4 (&v)[2][2][4][2], const Unit& u, int wr, int wc, int fr, int fq) const {
        const int t = u.pn >> 3, colt = (u.pn & 7) * BM;
        const int row0 = u.pm * BM + wr * 64 + fr;
        const int hl = wc >> 1, ch = (wc & 1) * 64 + 8 * fq;
        const bool odd = (fr & 1) != 0;
        const int colx = colt + wc * 64 + 8 * fq + (odd ? 32 : 0);
        const unsigned offA = (unsigned)((row0 & ~1) * ldc + colx) * 2u, offB = offA + (unsigned)ldc * 2u;
        bf16_t* base = O + (size_t)t * split_stride;
        const PG8_LAS float* tb = tab + (u.idx & 1) * BM + wr * 64 + fr;
        f32x4 csq[2][2];
        if constexpr (I8) {
#pragma unroll
            for (int bj = 0; bj < 2; ++bj)
#pragma unroll
                for (int n = 0; n < 2; ++n) csq[bj][n] = *(const f32x4*)(colmax + u.pn * BM + wc * 64 + 32 * bj + 8 * fq + 4 * n) * (1.0f / 127.0f); }
#pragma unroll
        for (int ai = 0; ai < 2; ++ai)
#pragma unroll
            for (int m = 0; m < 4; ++m) { const float r = tb[ai * HALF + m * 16];
#pragma unroll
                for (int bj = 0; bj < 2; ++bj) {
                    if constexpr (I8) { const i32x4 i0 = __builtin_bit_cast(i32x4, v[ai][bj][m][0]), i1 = __builtin_bit_cast(i32x4, v[ai][bj][m][1]);
                        v[ai][bj][m][0] = (f32x4){(float)i0[0], (float)i0[1], (float)i0[2], (float)i0[3]} * csq[bj][0] * r; v[ai][bj][m][1] = (f32x4){(float)i1[0], (float)i1[1], (float)i1[2], (float)i1[3]} * csq[bj][1] * r; }
                    else { v[ai][bj][m][0] = v[ai][bj][m][0] * r; v[ai][bj][m][1] = v[ai][bj][m][1] * r; } } }
        if (t < 2) {
#pragma unroll
            for (int ai = 0; ai < 2; ++ai)
#pragma unroll
                for (int m = 0; m < 4; ++m) { float ss = 0.f;
#pragma unroll
                    for (int bj = 0; bj < 2; ++bj) { const f32x4 x0 = v[ai][bj][m][0], x1 = v[ai][bj][m][1];
                        ss += ((x0[0] * x0[0] + x0[1] * x0[1]) + (x0[2] * x0[2] + x0[3] * x0[3])) + ((x1[0] * x1[0] + x1[1] * x1[1]) + (x1[2] * x1[2] + x1[3] * x1[3])); }
                    ss += __shfl_xor(ss, 16); ss += __shfl_xor(ss, 32);
                    if (fq == 0) xch[(hl * BM + ai * HALF + wr * 64 + m * 16 + fr) * 2 + (wc & 1)] = ss; }
            asm volatile("s_waitcnt lgkmcnt(0)" ::: "memory"); __builtin_amdgcn_s_barrier(); asm volatile("" ::: "memory");
            const float* gain = (t == 0) ? q_gain : k_gain;
            f32x4 g[2][2];
#pragma unroll
            for (int bj = 0; bj < 2; ++bj)
#pragma unroll
                for (int n = 0; n < 2; ++n) g[bj][n] = *(const f32x4*)(gain + ch + 32 * bj + 4 * n);
#pragma unroll
            for (int ai = 0; ai < 2; ++ai)
#pragma unroll
                for (int m = 0; m < 4; ++m) { const PG8_LAS float* sp = xch + (hl * BM + ai * HALF + wr * 64 + m * 16 + fr) * 2;
                    const float rh = 1.0f / sqrtf((sp[0] + sp[1]) * (1.0f / 128.0f) + eps);
#pragma unroll
                    for (int bj = 0; bj < 2; ++bj) { v[ai][bj][m][0] = v[ai][bj][m][0] * rh * g[bj][0]; v[ai][bj][m][1] = v[ai][bj][m][1] * rh * g[bj][1]; } }
            if (t == 1) {
#pragma unroll
                for (int bj = 0; bj < 2; ++bj) { f32x4 s0 = {0.f, 0.f, 0.f, 0.f}, s1 = {0.f, 0.f, 0.f, 0.f};
#pragma unroll
                    for (int ai = 0; ai < 2; ++ai)
#pragma unroll
                        for (int m = 0; m < 4; ++m) { s0 = s0 + v[ai][bj][m][0]; s1 = s1 + v[ai][bj][m][1]; }
#pragma unroll
                    for (int e = 0; e < 4; ++e) {
#pragma unroll
                        for (int o = 1; o < 16; o <<= 1) { s0[e] += __shfl_xor(s0[e], o); s1[e] += __shfl_xor(s1[e], o); } }
                    if (fr == 0) { const int b = u.pm / nblk, blk = u.pm % nblk, h = (u.pn & 7) * 2 + hl;
                        float* dst = kmp + ((((size_t)(b * nh + h) * nblk + blk) * 2 + wr) * 128 + ch + 32 * bj);
                        *(f32x4*)dst = s0 * (1.0f / 256.0f); *(f32x4*)(dst + 4) = s1 * (1.0f / 256.0f); } }
            }
        }
#pragma unroll
        for (int ai = 0; ai < 2; ++ai)
#pragma unroll
            for (int m = 0; m < 4; ++m) {
                u32x4 w[2];
#pragma unroll
                for (int bj = 0; bj < 2; ++bj) { const f32x4 v0 = v[ai][bj][m][0], v1 = v[ai][bj][m][1];
                    w[bj].x = cvt_pk_bf16(v0[0], v0[1]); w[bj].y = cvt_pk_bf16(v0[2], v0[3]); w[bj].z = cvt_pk_bf16(v1[0], v1[1]); w[bj].w = cvt_pk_bf16(v1[2], v1[3]); }
                pair_lines(w[0], w[1], odd);
                char* pr = (char*)base + (size_t)(ai * HALF + m * 16) * ldc * 2; *(u32x4*)(pr + offA) = w[0]; *(u32x4*)(pr + offB) = w[1]; }
    }
};
typedef EpiQKVT<false> EpiQKV;
template <bool FINAL, bool I8_ = false, bool OFFS = false> struct EpiResB {
    static constexpr bool PERM = true, AFTER_DRAIN = false, I8 = I8_;
    bf16_t* xb; int ldx; float* out; int ldo; float* rss; const PG8_LAS float* tab; const float* colmax; const int* colsum;
    __device__ __forceinline__ void operator()(const f32x4 (&acc)[2][2][4][2], const Unit& u, int wr, int wc, int fr, int fq) const {
        const int row0 = u.pm * BM + wr * 64 + fr, col0 = u.pn * BM + wc * 64 + 8 * fq;
        const bool odd = (fr & 1) != 0;
        const int colx = col0 + (odd ? 32 : 0);
        const unsigned offA = (unsigned)((row0 & ~1) * ldx + colx) * 2u, offB = offA + (unsigned)ldx * 2u;
        f32x4 cs[2][2], oc[2][2];
        if constexpr (I8) {
#pragma unroll
            for (int bj = 0; bj < 2; ++bj)
#pragma unroll
                for (int n = 0; n < 2; ++n) { cs[bj][n] = *(const f32x4*)(colmax + col0 + 32 * bj + 4 * n) * (1.0f / 127.0f);
                    if constexpr (OFFS) { const i32x4 s = *(const i32x4*)(colsum + col0 + 32 * bj + 4 * n);
                        oc[bj][n] = (f32x4){(float)s[0], (float)s[1], (float)s[2], (float)s[3]} * 128.0f * cs[bj][n]; } } }
        constexpr int NH_ = OFFS ? 1 : 2;
        u32x4 w[NH_][4][2];
        if constexpr (!OFFS) {
#pragma unroll
            for (int ai = 0; ai < 2; ++ai)
#pragma unroll
                for (int m = 0; m < 4; ++m) { const char* pr = (const char*)xb + (size_t)(ai * HALF + m * 16) * ldx * 2;
                    w[ai][m][0] = *(const u32x4*)(pr + offA); w[ai][m][1] = *(const u32x4*)(pr + offB); } }
#pragma unroll
        for (int ai = 0; ai < 2; ++ai) {
            const int wi = OFFS ? 0 : ai;
            if constexpr (OFFS) {
#pragma unroll
                for (int m = 0; m < 4; ++m) { const char* pr = (const char*)xb + (size_t)(ai * HALF + m * 16) * ldx * 2;
                    w[0][m][0] = *(const u32x4*)(pr + offA); w[0][m][1] = *(const u32x4*)(pr + offB); } }
#pragma unroll
            for (int m = 0; m < 4; ++m) { const int row = row0 + ai * HALF + m * 16;
                const float rsc = I8 ? tab[(u.idx & 1) * BM + wr * 64 + fr + ai * HALF + m * 16] : 1.0f;
                pair_lines(w[wi][m][0], w[wi][m][1], odd);
                float ss = 0.f; u32x4 o[2];
#pragma unroll
                for (int bj = 0; bj < 2; ++bj) {
                    const u32x4 wv = w[wi][m][bj];
                    f32x4 x0, x1;
                    x0[0] = __uint_as_float(wv.x << 16); x0[1] = __uint_as_float(wv.x & 0xffff0000u); x0[2] = __uint_as_float(wv.y << 16); x0[3] = __uint_as_float(wv.y & 0xffff0000u);
                    x1[0] = __uint_as_float(wv.z << 16); x1[1] = __uint_as_float(wv.z & 0xffff0000u); x1[2] = __uint_as_float(wv.w << 16); x1[3] = __uint_as_float(wv.w & 0xffff0000u);
                    if constexpr (I8) { const i32x4 i0 = __builtin_bit_cast(i32x4, acc[ai][bj][m][0]), i1 = __builtin_bit_cast(i32x4, acc[ai][bj][m][1]);
                        f32x4 a0 = (f32x4){(float)i0[0], (float)i0[1], (float)i0[2], (float)i0[3]} * cs[bj][0], a1 = (f32x4){(float)i1[0], (float)i1[1], (float)i1[2], (float)i1[3]} * cs[bj][1];
                        if constexpr (OFFS) { a0 = a0 + oc[bj][0]; a1 = a1 + oc[bj][1]; }
                        x0 = x0 + a0 * rsc; x1 = x1 + a1 * rsc; }
                    else { x0 = x0 + acc[ai][bj][m][0]; x1 = x1 + acc[ai][bj][m][1]; }
                    if (FINAL) { float* op = out + (size_t)row * ldo + col0 + 32 * bj; *(f32x4*)op = x0; *(f32x4*)(op + 4) = x1; }
                    else {
                        ss += ((x0[0] * x0[0] + x0[1] * x0[1]) + (x0[2] * x0[2] + x0[3] * x0[3])) + ((x1[0] * x1[0] + x1[1] * x1[1]) + (x1[2] * x1[2] + x1[3] * x1[3]));
                        o[bj].x = cvt_pk_bf16(x0[0], x0[1]); o[bj].y = cvt_pk_bf16(x0[2], x0[3]); o[bj].z = cvt_pk_bf16(x1[0], x1[1]); o[bj].w = cvt_pk_bf16(x1[2], x1[3]); } }
                if (!FINAL) {
                    pair_lines(o[0], o[1], odd);
                    char* pr = (char*)xb + (size_t)(ai * HALF + m * 16) * ldx * 2; *(u32x4*)(pr + offA) = o[0]; *(u32x4*)(pr + offB) = o[1];
                    ss += __shfl_xor(ss, 16); ss += __shfl_xor(ss, 32); if (fq == 0) rss[(size_t)row * RSS_PER_ROW + u.pn * 4 + wc] = ss; }
            }
        }
    }
};
}

#ifndef PG8_SP2
#define PG8_SP2 true
#endif
#ifndef PG8_ALIGN
#define PG8_ALIGN true
#endif
constexpr int NWAVES = 8;
constexpr int NB = 2, SEQ = 16384, DM = 2048, M = NB * SEQ, DFF = 8192, NMIX = 5120, NQKV = 6144, NH = 16, HD = 128, BLK = 256, NBLK = SEQ / BLK;
constexpr int CW = 1024, SGW = 1024, SGG = 8, SGD = 128, SGC = 128;
constexpr float EPS = 1e-6f;
constexpr int N_PHASES = 17;
constexpr size_t MiB = 1u << 20;
constexpr size_t WS_CTL = 0, CTL_ZERO_BYTES = 256 * 1024;
constexpr size_t WS_CMAX_DN = 184 * 1024;
constexpr size_t WS_CSUM_DN = 200 * 1024;
constexpr size_t WS_HROWS = 13 * MiB + 768 * 1024;
constexpr size_t WS_CMAX_QKV = 160 * 1024;
constexpr size_t WS_CMAX_O = 152 * 1024;
constexpr size_t WS_CMAX_IN = 128 * 1024;
constexpr size_t WS_CMAX = 64 * 1024;
constexpr size_t WS_ROWS = 13 * MiB + 512 * 1024;
constexpr size_t WS_KMP = 1 * MiB;
constexpr size_t WS_SEL = 3 * MiB;
constexpr size_t WS_LS = 5 * MiB;
constexpr size_t WS_RSS = 14 * MiB;
constexpr size_t WS_WSB = 13 * MiB;
constexpr size_t WS_WIN = 18 * MiB, WS_WOUT = 38 * MiB, WS_WUP0 = 46 * MiB, WS_WDN0 = 78 * MiB, WS_WQKV = 110 * MiB, WS_WO = 134 * MiB, WS_WUP1 = 142 * MiB, WS_WDN1 = 174 * MiB;
constexpr size_t WS_HB = 206 * MiB;
constexpr size_t WS_BIG = 334 * MiB;
constexpr size_t WS_Z = WS_BIG, WS_CAT = WS_BIG + 320 * MiB, WS_HID = WS_BIG, WS_Q = WS_BIG, WS_K = WS_BIG + 128 * MiB, WS_V = WS_BIG + 256 * MiB;
constexpr size_t WS_PO0 = WS_BIG + 384 * MiB, WS_PO1 = WS_BIG + 512 * MiB, WS_PO2 = WS_HB;
constexpr size_t WS_XQ = WS_PO1;
constexpr size_t WS_END = WS_PO1 + 128 * MiB;
static_assert(WS_END <= 1024 * MiB, "workspace map");
constexpr int CW_QUEUE = 6144;
constexpr int CW_GBAR = 55296;
constexpr int CW_SELQ = 512;
constexpr int CW_BAR = 1024;
constexpr int RING_OFF = 0, RING_BYTES = 131072, LDSCTL_OFF = 149504, MISC_OFF = LDSCTL_OFF + 320, RINV_OFF = 151552, XCH_OFF = 153600, LDS_BYTES = 161792;

#define GAS __attribute__((address_space(1)))
#define LAS __attribute__((address_space(3)))
typedef unsigned short bf16;
typedef unsigned v4u __attribute__((ext_vector_type(4)));
typedef float f32x4 __attribute__((ext_vector_type(4)));
typedef short bf16x8 __attribute__((ext_vector_type(8)));
typedef GAS unsigned gu32;
typedef GAS unsigned long long gu64;
#define RLX_AGENT __ATOMIC_RELAXED, __HIP_MEMORY_SCOPE_AGENT
#define LDS_WAIT() asm volatile("s_waitcnt lgkmcnt(0)" ::: "memory")
#define VM_WAIT() asm volatile("s_waitcnt vmcnt(0)" ::: "memory")
__device__ __forceinline__ unsigned long long rt() { return __builtin_amdgcn_s_memrealtime(); }
__device__ __forceinline__ unsigned f2bf(float f) { unsigned u = __builtin_bit_cast(unsigned, f); return (u + 0x7fffu + ((u >> 16) & 1u)) >> 16; }
__device__ __forceinline__ unsigned pk2(float lo, float hi) { return f2bf(lo) | (f2bf(hi) << 16); }

#define XB_TMO      128
#define XB_XCNT(j)  (256  + 64 * (j))
#define XB_XSUB(j)  (1280 + 64 * (j))
#define XB_XGEN(j)  (2304 + 64 * (j))
#define XB_TOP      3328
#define XB_TOPGEN   3392
#define XCD_BAR_WORDS 3456
#define XB_SPIN_CAP (1u << 18)

__device__ __forceinline__ unsigned xb_ld(unsigned* p)              { return __hip_atomic_load(p, __ATOMIC_RELAXED, __HIP_MEMORY_SCOPE_AGENT); }
__device__ __forceinline__ unsigned xb_add(unsigned* p, unsigned v) { return __hip_atomic_fetch_add(p, v, __ATOMIC_RELAXED, __HIP_MEMORY_SCOPE_AGENT); }
__device__ __forceinline__ unsigned xb_xcc_id() { return (unsigned)__builtin_amdgcn_s_getreg((3 << 11) | 20) & 0xFu; }
#define XB_SPIN(cond, bar) do { unsigned _sp = 0; while (cond) { __builtin_amdgcn_s_sleep(1); \
    if ((++_sp & 255u) == 0u) { if (xb_ld(&(bar)[XB_TMO])) break; if (_sp > XB_SPIN_CAP) { atomicAdd(&(bar)[XB_TMO], 1u); break; } } } } while (0)

struct XcdBarrier {
    unsigned* bar; unsigned x;
    volatile LAS unsigned* st;
};

__device__ __forceinline__ XcdBarrier xcd_barrier_post(unsigned* bar, volatile LAS unsigned* st) {
    XcdBarrier b; b.bar = bar; b.x = xb_xcc_id(); b.st = st;
    if (threadIdx.x == 0) (void)xb_add(&bar[XB_XCNT(b.x)], 1u);
    return b;
}
__device__ __forceinline__ void xcd_barrier_complete(unsigned* bar, unsigned x, unsigned& nloc, unsigned& nx) {
    const unsigned G = gridDim.x * gridDim.y * gridDim.z;
    unsigned sum, cnt, mine, sp = 0u;
    for (;;) {
        sum = 0u; cnt = 0u; mine = 0u;
#pragma unroll
        for (unsigned j = 0; j < 16; ++j) { const unsigned c = xb_ld(&bar[XB_XCNT(j)]); sum += c; cnt += (c > 0u) ? 1u : 0u; mine = (j == x) ? c : mine; }
        if (sum == G) break;
        __builtin_amdgcn_s_sleep(1);
        if ((++sp & 255u) == 0u) { if (xb_ld(&bar[XB_TMO])) break; if (sp > XB_SPIN_CAP) { atomicAdd(&bar[XB_TMO], 1u); break; } }
    }
    nloc = mine > 0u ? mine : 1u; nx = cnt > 0u ? cnt : 1u;
}

__device__ __forceinline__ void xcd_barrier(const XcdBarrier& b) {
    asm volatile("s_waitcnt vmcnt(0)" ::: "memory");
    __syncthreads();
    if (threadIdx.x == 0) {
        unsigned* bar = b.bar;
        __builtin_amdgcn_s_waitcnt(0);
        unsigned nloc = b.st[0], nx = b.st[1];
        if (nloc == 0u) { xcd_barrier_complete(bar, b.x, nloc, nx); b.st[0] = nloc; b.st[1] = nx; }
        const unsigned old = xb_add(&bar[XB_XSUB(b.x)], 1u);
        const unsigned gen = old / nloc;
        if (old + 1u == (gen + 1u) * nloc) {
            __builtin_amdgcn_fence(__ATOMIC_RELEASE, "agent");
            asm volatile("s_waitcnt vmcnt(0)" ::: "memory");
            const unsigned og = xb_add(&bar[XB_TOP], 1u);
            const unsigned tg = og / nx;
            if (og + 1u == (tg + 1u) * nx) xb_add(&bar[XB_TOPGEN], 1u);
            else XB_SPIN(xb_ld(&bar[XB_TOPGEN]) == tg, bar);
            __builtin_amdgcn_fence(__ATOMIC_ACQUIRE, "agent");
            xb_add(&bar[XB_XGEN(b.x)], 1u);
            asm volatile("s_waitcnt vmcnt(0)" ::: "memory");
        } else {
            XB_SPIN(xb_ld(&bar[XB_XGEN(b.x)]) == gen, bar);
            __builtin_amdgcn_fence(__ATOMIC_ACQUIRE, "agent");
            asm volatile("s_waitcnt vmcnt(0)" ::: "memory");
        }
    }
    __syncthreads();
}

typedef short s16x4 __attribute__((ext_vector_type(4)));
typedef unsigned u32x2v __attribute__((ext_vector_type(2)));
__device__ __forceinline__ float bf_lo(unsigned w) { return __uint_as_float(w << 16); }
__device__ __forceinline__ float bf_hi(unsigned w) { return __uint_as_float(w & 0xffff0000u); }
__device__ __forceinline__ void unpack8(const v4u w, float (&f)[8]) {
    f[0] = bf_lo(w.x); f[1] = bf_hi(w.x); f[2] = bf_lo(w.y); f[3] = bf_hi(w.y); f[4] = bf_lo(w.z); f[5] = bf_hi(w.z); f[6] = bf_lo(w.w); f[7] = bf_hi(w.w); }
__device__ __forceinline__ v4u pack8(const float (&f)[8]) { v4u w; w.x = pk2(f[0], f[1]); w.y = pk2(f[2], f[3]); w.z = pk2(f[4], f[5]); w.w = pk2(f[6], f[7]); return w; }
__device__ __forceinline__ float wave_sum(float v) {
#pragma unroll
    for (int o = 1; o < 64; o <<= 1) v += __shfl_xor(v, o);
    return v;
}
__device__ __forceinline__ float wave_max(float v) {
#pragma unroll
    for (int o = 1; o < 64; o <<= 1) v = fmaxf(v, __shfl_xor(v, o));
    return v;
}
constexpr int TP_PITCH = 144;
__device__ __forceinline__ void p0_transpose_item(const float* W, int K, int N, bf16* WT, LAS unsigned char* scr, int item, int lane, const float* gain) {
    const int nq = N / 256, sup = item >> 3, w8 = item & 7, kb = 2 * (sup / nq) + (w8 >> 2), nb = 4 * (sup % nq) + (w8 & 3), k0 = 64 * kb, n0 = 64 * nb;
    const int lr = lane >> 4, lc = lane & 15;
    f32x4 v[16]; float g[16];
#pragma unroll
    for (int i = 0; i < 16; ++i) { v[i] = *(const GAS f32x4*)(W + (size_t)(k0 + 4 * i + lr) * N + n0 + 4 * lc); g[i] = gain ? gain[k0 + 4 * i + lr] : 1.0f; }
#pragma unroll
    for (int i = 0; i < 16; ++i) { u32x2v w; w.x = pk2(v[i].x * g[i], v[i].y * g[i]); w.y = pk2(v[i].z * g[i], v[i].w * g[i]); *(LAS u32x2v*)(scr + (4 * i + lr) * TP_PITCH + lc * 8) = w; }
    LDS_WAIT(); asm volatile("" ::: "memory");
    const int G4 = lane >> 4, q4 = (lane >> 2) & 3, p4 = lane & 3;
#pragma unroll
    for (int nbk = 0; nbk < 4; ++nbk)
#pragma unroll
        for (int kh = 0; kh < 2; ++kh) {
            const unsigned addr = (unsigned)(uintptr_t)scr + (unsigned)((32 * kh + 8 * G4 + q4) * TP_PITCH + (16 * nbk + 4 * p4) * 2);
            s16x4 lo, hi;
            asm volatile("ds_read_b64_tr_b16 %0, %2\n\tds_read_b64_tr_b16 %1, %2 offset:%3\n\ts_waitcnt lgkmcnt(0)" : "=&v"(lo), "=&v"(hi) : "v"(addr), "i"(4 * TP_PITCH) : "memory");
            const bf16x8 o = (bf16x8){lo[0], lo[1], lo[2], lo[3], hi[0], hi[1], hi[2], hi[3]};
            *(GAS bf16x8*)(WT + (size_t)(n0 + 16 * nbk + (lane & 15)) * K + k0 + 32 * kh + 8 * G4) = o;
        }
    asm volatile("" ::: "memory");
}
__device__ __forceinline__ void up_absmax_item(const float* W, int K, int N, unsigned* CMAX, int item, int lane, const float* gain, int ldw = 0) {
    if (ldw == 0) ldw = N;
    const int nq = N / 256, sup = item >> 3, w8 = item & 7, kb = 2 * (sup / nq) + (w8 >> 2), nb = 4 * (sup % nq) + (w8 & 3), k0 = 64 * kb, n0 = 64 * nb;
    const int lr = lane >> 4, lc = lane & 15;
    f32x4 v[16]; float g[16];
#pragma unroll
    for (int i = 0; i < 16; ++i) { v[i] = *(const GAS f32x4*)(W + (size_t)(k0 + 4 * i + lr) * ldw + n0 + 4 * lc); g[i] = gain ? gain[k0 + 4 * i + lr] : 1.0f; }
    f32x4 mx = {0.f, 0.f, 0.f, 0.f};
#pragma unroll
    for (int i = 0; i < 16; ++i) { mx.x = fmaxf(mx.x, fabsf(v[i].x * g[i])); mx.y = fmaxf(mx.y, fabsf(v[i].y * g[i])); mx.z = fmaxf(mx.z, fabsf(v[i].z * g[i])); mx.w = fmaxf(mx.w, fabsf(v[i].w * g[i])); }
#pragma unroll
    for (int e = 0; e < 4; ++e) { mx[e] = fmaxf(mx[e], __shfl_xor(mx[e], 16)); mx[e] = fmaxf(mx[e], __shfl_xor(mx[e], 32)); }
    if (lr == 0) {
#pragma unroll
        for (int e = 0; e < 4; ++e) atomicMax(CMAX + n0 + 4 * lc + e, __float_as_uint(mx[e])); }
}
__device__ __forceinline__ unsigned q4_pack(float a, float b, float c, float d) {
    unsigned r = 0u;
    r = __builtin_amdgcn_cvt_pk_u8_f32(a + 128.f, 0, r); r = __builtin_amdgcn_cvt_pk_u8_f32(b + 128.f, 1, r); r = __builtin_amdgcn_cvt_pk_u8_f32(c + 128.f, 2, r); r = __builtin_amdgcn_cvt_pk_u8_f32(d + 128.f, 3, r);
    return r ^ 0x80808080u;
}
__device__ __forceinline__ void up_quant_item(const float* W, int K, int N, signed char* WQ, const float* CMAXF, LAS unsigned char* scr, int item, int lane, const float* gain, int* CSUM = nullptr, int ldw = 0) {
    if (ldw == 0) ldw = N;
    const int nq = N / 256, sup = item >> 3, w8 = item & 7, kb = 2 * (sup / nq) + (w8 >> 2), nb = 4 * (sup % nq) + (w8 & 3), k0 = 64 * kb, n0 = 64 * nb;
    const int lr = lane >> 4, lc = lane & 15;
    f32x4 v[16]; float g[16];
#pragma unroll
    for (int i = 0; i < 16; ++i) { v[i] = *(const GAS f32x4*)(W + (size_t)(k0 + 4 * i + lr) * ldw + n0 + 4 * lc); g[i] = gain ? gain[k0 + 4 * i + lr] : 1.0f; }
    const f32x4 cm = *(const GAS f32x4*)(CMAXF + n0 + 4 * lc);
    f32x4 inv; inv.x = cm.x > 0.f ? 127.0f / cm.x : 0.f; inv.y = cm.y > 0.f ? 127.0f / cm.y : 0.f; inv.z = cm.z > 0.f ? 127.0f / cm.z : 0.f; inv.w = cm.w > 0.f ? 127.0f / cm.w : 0.f;
    f32x4 csum = {0.f, 0.f, 0.f, 0.f};
#pragma unroll
    for (int i = 0; i < 16; ++i) { const f32x4 q = {__builtin_rintf(v[i].x * g[i] * inv.x), __builtin_rintf(v[i].y * g[i] * inv.y), __builtin_rintf(v[i].z * g[i] * inv.z), __builtin_rintf(v[i].w * g[i] * inv.w)};
        csum = csum + q;
        u32x2v w; w.x = pk2(q.x, q.y); w.y = pk2(q.z, q.w);
        *(LAS u32x2v*)(scr + (4 * i + lr) * TP_PITCH + lc * 8) = w; }
    if (CSUM) {
#pragma unroll
        for (int e = 0; e < 4; ++e) { csum[e] += __shfl_xor(csum[e], 16); csum[e] += __shfl_xor(csum[e], 32); }
        if (lr == 0) {
#pragma unroll
            for (int e = 0; e < 4; ++e) atomicAdd(CSUM + n0 + 4 * lc + e, (int)csum[e]); } }
    LDS_WAIT(); asm volatile("" ::: "memory");
    const int G4 = lane >> 4, q4 = (lane >> 2) & 3, p4 = lane & 3;
#pragma unroll
    for (int nbk = 0; nbk < 4; ++nbk)
#pragma unroll
        for (int kh = 0; kh < 2; ++kh) {
            const unsigned addr = (unsigned)(uintptr_t)scr + (unsigned)((32 * kh + 8 * G4 + q4) * TP_PITCH + (16 * nbk + 4 * p4) * 2);
            s16x4 lo, hi;
            asm volatile("ds_read_b64_tr_b16 %0, %2\n\tds_read_b64_tr_b16 %1, %2 offset:%3\n\ts_waitcnt lgkmcnt(0)" : "=&v"(lo), "=&v"(hi) : "v"(addr), "i"(4 * TP_PITCH) : "memory");
#define BF_F(S) __uint_as_float((unsigned)(unsigned short)(S) << 16)
            u32x2v o; o.x = q4_pack(BF_F(lo[0]), BF_F(lo[1]), BF_F(lo[2]), BF_F(lo[3])); o.y = q4_pack(BF_F(hi[0]), BF_F(hi[1]), BF_F(hi[2]), BF_F(hi[3]));
#undef BF_F
            *(GAS u32x2v*)(WQ + (size_t)(n0 + 16 * nbk + (lane & 15)) * K + k0 + 32 * kh + 8 * G4) = o;
        }
    asm volatile("" ::: "memory");
}
__device__ __forceinline__ void hq_rows(bf16* HID, float* HROWS, int row0, int nrows, int gw, int ngw, int lane) {
    asm volatile("" : "+v"(lane));
    for (int m = row0 + gw; m < row0 + nrows; m += ngw) {
        bf16* slot = HID + (size_t)(m >> 8) * (32 * 65536) + (size_t)(m & 255) * 256 + (size_t)(lane >> 5) * 65536;
        v4u v[16];
#pragma unroll
        for (int j = 0; j < 16; ++j) v[j] = *(const GAS v4u*)(slot + (size_t)j * (2 * 65536) + (lane & 31) * 8);
        float amax = 0.f;
#pragma unroll
        for (int j = 0; j < 16; ++j)
#pragma unroll
            for (int c = 0; c < 4; ++c) { const unsigned w = v[j][c]; amax = fmaxf(amax, fmaxf(__uint_as_float(w << 16), __uint_as_float(w & 0xffff0000u))); }
        amax = wave_max(amax);
        const float inv = amax > 0.f ? 255.0f / amax : 0.f;
#pragma unroll
        for (int j = 0; j < 16; ++j) { unsigned o[2];
#pragma unroll
            for (int h = 0; h < 2; ++h) { const unsigned w0 = v[j][2 * h], w1 = v[j][2 * h + 1]; unsigned r = 0u;
                r = __builtin_amdgcn_cvt_pk_u8_f32(__builtin_rintf(__uint_as_float(w0 << 16) * inv), 0, r); r = __builtin_amdgcn_cvt_pk_u8_f32(__builtin_rintf(__uint_as_float(w0 & 0xffff0000u) * inv), 1, r);
                r = __builtin_amdgcn_cvt_pk_u8_f32(__builtin_rintf(__uint_as_float(w1 << 16) * inv), 2, r); r = __builtin_amdgcn_cvt_pk_u8_f32(__builtin_rintf(__uint_as_float(w1 & 0xffff0000u) * inv), 3, r);
                o[h] = r ^ 0x80808080u; }
            u32x2v ov; ov.x = o[0]; ov.y = o[1];
            *(GAS u32x2v*)((char*)(slot + (size_t)j * (2 * 65536)) + (lane & 31) * 8) = ov; }
        if (lane == 0) HROWS[m] = amax * (1.0f / 255.0f);
    }
}
template <bool NORM> __device__ __forceinline__ void xq_rows(const bf16* XB, signed char* XQ, float* ROWS, int gw, int ngw, int lane) {
    asm volatile("" : "+v"(lane));
    for (int m = 2 * gw; m < M; m += 2 * ngw) {
        const GAS v4u* xr = (const GAS v4u*)(XB + (size_t)m * DM) + lane;
        v4u v[2][4];
#pragma unroll
        for (int j = 0; j < 4; ++j) { v[0][j] = xr[64 * j]; v[1][j] = xr[DM / 8 + 64 * j]; }
#pragma unroll
        for (int r = 0; r < 2; ++r) {
            float f[4][8]; float amax = 0.f, ss = 0.f;
#pragma unroll
            for (int j = 0; j < 4; ++j)
#pragma unroll
                for (int c = 0; c < 4; ++c) { const unsigned w = v[r][j][c]; f[j][2 * c] = __uint_as_float(w << 16); f[j][2 * c + 1] = __uint_as_float(w & 0xffff0000u); }
#pragma unroll
            for (int j = 0; j < 4; ++j)
#pragma unroll
                for (int c = 0; c < 8; ++c) { amax = fmaxf(amax, fabsf(f[j][c])); ss += f[j][c] * f[j][c]; }
            amax = wave_max(amax); ss = wave_sum(ss);
            const float inv = amax > 0.f ? 127.0f / amax : 0.f;
            GAS u32x2v* o8 = (GAS u32x2v*)(XQ + (size_t)(m + r) * DM) + lane;
#pragma unroll
            for (int j = 0; j < 4; ++j) { u32x2v o;
                o.x = q4_pack(__builtin_rintf(f[j][0] * inv), __builtin_rintf(f[j][1] * inv), __builtin_rintf(f[j][2] * inv), __builtin_rintf(f[j][3] * inv));
                o.y = q4_pack(__builtin_rintf(f[j][4] * inv), __builtin_rintf(f[j][5] * inv), __builtin_rintf(f[j][6] * inv), __builtin_rintf(f[j][7] * inv));
                o8[64 * j] = o; }
            if (lane == 0) ROWS[m + r] = amax * (1.0f / 127.0f) * (NORM ? 1.0f / sqrtf(ss * (1.0f / DM) + EPS) : 1.0f);
        }
    }
}
__device__ __forceinline__ void xb_rows(const float* X, bf16* XB, float* RSS, signed char* XQ, float* ROWS, int gw, int ngw, int lane) {
    for (int m = 2 * gw; m < M; m += 2 * ngw) {
        const GAS f32x4* xr = (const GAS f32x4*)(X + (size_t)m * DM) + lane;
        f32x4 v[2][8]; float s0 = 0.f, s1 = 0.f;
#pragma unroll
        for (int j = 0; j < 8; ++j) { v[0][j] = xr[64 * j]; v[1][j] = xr[DM / 4 + 64 * j]; }
#pragma unroll
        for (int j = 0; j < 8; ++j) { s0 += (v[0][j].x * v[0][j].x + v[0][j].y * v[0][j].y) + (v[0][j].z * v[0][j].z + v[0][j].w * v[0][j].w);
                                      s1 += (v[1][j].x * v[1][j].x + v[1][j].y * v[1][j].y) + (v[1][j].z * v[1][j].z + v[1][j].w * v[1][j].w); }
        s0 = wave_sum(s0); s1 = wave_sum(s1);
        {
            float a0 = 0.f, a1 = 0.f;
#pragma unroll
            for (int j = 0; j < 8; ++j) { a0 = fmaxf(a0, fmaxf(fmaxf(fabsf(v[0][j].x), fabsf(v[0][j].y)), fmaxf(fabsf(v[0][j].z), fabsf(v[0][j].w))));
                                          a1 = fmaxf(a1, fmaxf(fmaxf(fabsf(v[1][j].x), fabsf(v[1][j].y)), fmaxf(fabsf(v[1][j].z), fabsf(v[1][j].w)))); }
            a0 = wave_max(a0); a1 = wave_max(a1);
            const float i0 = a0 > 0.f ? 127.0f / a0 : 0.f, i1 = a1 > 0.f ? 127.0f / a1 : 0.f;
            GAS unsigned* q0 = (GAS unsigned*)(XQ + (size_t)m * DM) + lane; GAS unsigned* q1 = (GAS unsigned*)(XQ + (size_t)(m + 1) * DM) + lane;
#pragma unroll
            for (int j = 0; j < 8; ++j) { q0[64 * j] = q4_pack(__builtin_rintf(v[0][j].x * i0), __builtin_rintf(v[0][j].y * i0), __builtin_rintf(v[0][j].z * i0), __builtin_rintf(v[0][j].w * i0));
                                          q1[64 * j] = q4_pack(__builtin_rintf(v[1][j].x * i1), __builtin_rintf(v[1][j].y * i1), __builtin_rintf(v[1][j].z * i1), __builtin_rintf(v[1][j].w * i1)); }
            if (lane == 0) { ROWS[m] = a0 * (1.0f / 127.0f) * (1.0f / sqrtf(s0 * (1.0f / DM) + EPS)); ROWS[m + 1] = a1 * (1.0f / 127.0f) * (1.0f / sqrtf(s1 * (1.0f / DM) + EPS)); }
        }
        GAS u32x2v* o8 = (GAS u32x2v*)(XB + (size_t)m * DM) + lane;
#pragma unroll
        for (int j = 0; j < 8; ++j) { u32x2v w; w.x = pk2(v[0][j].x, v[0][j].y); w.y = pk2(v[0][j].z, v[0][j].w); o8[64 * j] = w;
                                      u32x2v w1; w1.x = pk2(v[1][j].x, v[1][j].y); w1.y = pk2(v[1][j].z, v[1][j].w); o8[DM / 4 + 64 * j] = w1; }
        if (lane < pg8::RSS_PER_ROW) { RSS[(size_t)m * pg8::RSS_PER_ROW + lane] = (lane == 0) ? s0 : 0.f; RSS[(size_t)(m + 1) * pg8::RSS_PER_ROW + lane] = (lane == 0) ? s1 : 0.f; }
    }
}
constexpr int VN_PITCH = 544;
__device__ __forceinline__ void mixer_unit(int unit, const bf16* Z, bf16* CAT, const float* conv_w, const float* sgu_gain, const bf16* WSB, const float* b_s, LAS unsigned char* lds, int tid) {
    const int m0 = unit * SGC, lane = tid & 63, wid = tid >> 6;
    {
        const int cc = tid & 127, rg = tid >> 7, ch0 = 8 * cc;
        float w0[8], w1[8], w2[8];
#pragma unroll
        for (int e = 0; e < 8; ++e) { w0[e] = conv_w[(ch0 + e) * 3 + 0]; w1[e] = conv_w[(ch0 + e) * 3 + 1]; w2[e] = conv_w[(ch0 + e) * 3 + 2]; }
        const int mf = m0 + 32 * rg;
        float ym2[8], ym1[8];
#pragma unroll
        for (int e = 0; e < 8; ++e) { ym2[e] = 0.f; ym1[e] = 0.f; }
        if ((mf % SEQ) >= 2) {
            float a[8], b[8];
            unpack8(*(const GAS v4u*)(Z + (size_t)(mf - 2) * NMIX + CW + ch0), a); unpack8(*(const GAS v4u*)(Z + (size_t)(mf - 2) * NMIX + 2 * CW + ch0), b);
#pragma unroll
            for (int e = 0; e < 8; ++e) ym2[e] = a[e] * b[e];
            unpack8(*(const GAS v4u*)(Z + (size_t)(mf - 1) * NMIX + CW + ch0), a); unpack8(*(const GAS v4u*)(Z + (size_t)(mf - 1) * NMIX + 2 * CW + ch0), b);
#pragma unroll
            for (int e = 0; e < 8; ++e) ym1[e] = a[e] * b[e];
        }
#pragma unroll 8
        for (int t = 0; t < 32; ++t) {
            const size_t m = (size_t)(mf + t);
            float gb[8], gc[8], xa[8], o[8];
            unpack8(*(const GAS v4u*)(Z + m * NMIX + ch0), gb); unpack8(*(const GAS v4u*)(Z + m * NMIX + CW + ch0), gc); unpack8(*(const GAS v4u*)(Z + m * NMIX + 2 * CW + ch0), xa);
#pragma unroll
            for (int e = 0; e < 8; ++e) { const float y = gc[e] * xa[e]; o[e] = gb[e] * (ym2[e] * w0[e] + ym1[e] * w1[e] + y * w2[e]); ym2[e] = ym1[e]; ym1[e] = y; }
            *(GAS v4u*)(CAT + m * DM + ch0) = pack8(o);
        }
    }
    constexpr int WL_OFF = 128 * VN_PITCH, WL_PITCH = 272;
    for (int gp = 0; gp < SGG; gp += 2) {
        {
            v4u vv[8], ww[8];
#pragma unroll
            for (int k = 0; k < 8; ++k) { const int p = tid + 512 * k, j = p >> 5, cp = p & 31;
                vv[k] = *(const GAS v4u*)(Z + (size_t)(m0 + j) * NMIX + 4 * CW + gp * SGD + cp * 8); }
#pragma unroll
            for (int k = 0; k < 8; ++k) { const int p = tid + 512 * k;
                ww[k] = *(const GAS v4u*)(WSB + (size_t)gp * 128 * 128 + (size_t)p * 8); }
#pragma unroll
            for (int k = 0; k < 8; ++k) { const int p = tid + 512 * k, j = p >> 5, cp = p & 31;
                float v[8]; unpack8(vv[k], v);
                float ss = 0.f;
#pragma unroll
                for (int e = 0; e < 8; ++e) ss += v[e] * v[e];
                ss += __shfl_xor(ss, 1); ss += __shfl_xor(ss, 2); ss += __shfl_xor(ss, 4); ss += __shfl_xor(ss, 8);
                const float rinv = 1.0f / sqrtf(ss * (1.0f / SGD) + EPS);
                const GAS f32x4* gp4 = (const GAS f32x4*)(sgu_gain + gp * SGD + cp * 8); const f32x4 g0 = gp4[0], g1 = gp4[1];
                float o[8] = {v[0] * rinv * g0.x, v[1] * rinv * g0.y, v[2] * rinv * g0.z, v[3] * rinv * g0.w, v[4] * rinv * g1.x, v[5] * rinv * g1.y, v[6] * rinv * g1.z, v[7] * rinv * g1.w};
                *(LAS v4u*)(lds + j * VN_PITCH + cp * 16) = pack8(o);
                *(LAS v4u*)(lds + WL_OFF + (p >> 4) * WL_PITCH + (p & 15) * 16) = ww[k]; }
        }
        LDS_WAIT(); __syncthreads();
        {
            const int gl = wid >> 2, g = gp + gl, dq = wid & 3;
            const int G4 = lane >> 4, q4 = (lane >> 2) & 3, p4 = lane & 3, fr = lane & 15;
            v4u uw[8];
#pragma unroll
            for (int it = 0; it < 8; ++it) uw[it] = *(const GAS v4u*)(Z + (size_t)(m0 + 16 * it + fr) * NMIX + 3 * CW + g * SGD + 32 * dq + 8 * G4);
            bf16x8 af[2][4];
#pragma unroll
            for (int dt = 0; dt < 2; ++dt)
#pragma unroll
                for (int ks = 0; ks < 4; ++ks) {
                    const unsigned addr = (unsigned)(uintptr_t)(lds) + (unsigned)((32 * ks + 8 * G4 + q4) * VN_PITCH + (gl * SGD + 32 * dq + 8 * p4 + 4 * dt) * 2);
                    s16x4 lo, hi;
                    asm volatile("ds_read_b64_tr_b16 %0, %2\n\tds_read_b64_tr_b16 %1, %2 offset:%3\n\ts_waitcnt lgkmcnt(0)" : "=&v"(lo), "=&v"(hi) : "v"(addr), "i"(4 * VN_PITCH) : "memory");
                    af[dt][ks] = (bf16x8){lo[0], lo[1], lo[2], lo[3], hi[0], hi[1], hi[2], hi[3]};
                }
            __builtin_amdgcn_sched_barrier(0);
#pragma unroll
            for (int it = 0; it < 8; ++it) {
                const int nks = it / 2 + 1;
                bf16x8 bfr[4];
#pragma unroll
                for (int ks = 0; ks < 4; ++ks) if (ks < nks) bfr[ks] = *(const LAS bf16x8*)(lds + WL_OFF + (gl * 128 + 16 * it + fr) * WL_PITCH + (32 * ks + 8 * G4) * 2);
                const int mt = m0 + 16 * it + fr;
                const float bias = b_s[g * SGC + 16 * it + fr];
                v4u ow;
#pragma unroll
                for (int dt = 0; dt < 2; ++dt) {
                    f32x4 acc = {0.f, 0.f, 0.f, 0.f};
#pragma unroll
                    for (int ks = 0; ks < 4; ++ks) if (ks < nks) acc = __builtin_amdgcn_mfma_f32_16x16x32_bf16(af[dt][ks], bfr[ks], acc, 0, 0, 0);
                    const unsigned ua = dt ? uw[it].z : uw[it].x, ub = dt ? uw[it].w : uw[it].y;
                    const unsigned oa = pk2(bf_lo(ua) * (acc[0] + bias), bf_hi(ua) * (acc[1] + bias)), ob = pk2(bf_lo(ub) * (acc[2] + bias), bf_hi(ub) * (acc[3] + bias));
                    if (dt) { ow.z = oa; ow.w = ob; } else { ow.x = oa; ow.y = ob; }
                }
                *(GAS v4u*)(CAT + (size_t)mt * DM + CW + g * SGD + 32 * dq + 8 * G4) = ow;
            }
        }
        __syncthreads();
    }
}

namespace att {
typedef float f32x16 __attribute__((ext_vector_type(16)));
constexpr float SCALE = 0.08838834764831845f, LOG2E = 1.4426950408889634f, CS = SCALE * LOG2E;
constexpr int KT = 16384;
constexpr int LDS_K = 0, LDS_V = 4 * KT, LDS_LIST = 8 * KT, LIST_CAP = 8192, LDS_CNT = LDS_LIST + 2 * LIST_CAP;
#define KSWZ(row, colB) ((row) * 256 + ((colB) ^ (((row) & 7) << 4)))
#define SBAR() __builtin_amdgcn_sched_barrier(0)
__device__ __forceinline__ int crow(int r, int hi) { return (r & 3) + 8 * (r >> 2) + 4 * hi; }
__device__ __forceinline__ unsigned cvtpk(float lo, float hi) { unsigned r; asm volatile("v_cvt_pk_bf16_f32 %0, %1, %2" : "=v"(r) : "v"(lo), "v"(hi)); return r; }
__device__ __forceinline__ int v_st(int k, int c) { const int kk = (k & ~0xC) | ((k & 4) << 1) | ((k & 8) >> 1); return ((kk >> 3) * 4 + (c >> 5)) * 512 + ((kk & 7) * 32 + (c & 31)) * 2; }
__device__ __forceinline__ int v_rd_base(int lane) { return ((lane & 3) << 3) | (((lane >> 2) & 3) << 6) | (((lane >> 4) & 1) << 5) | (((lane >> 5) & 1) << 8); }
constexpr int v_rd_off(int d0, int ks, int half) { return d0 * 512 + ks * 4096 + half * 2048; }
template <int OFF> __device__ __forceinline__ s16x4 tr_read(int vb) { s16x4 r; asm volatile("ds_read_b64_tr_b16 %0, %1 offset:%2" : "=&v"(r) : "v"(vb), "i"(OFF) : "memory"); return r; }
__device__ __forceinline__ void qkt(f32x16& p0, f32x16& p1, const LAS unsigned char* Ks, const bf16x8 (&qr)[8], int r32, int hi) {
    p0 = (f32x16){}; p1 = (f32x16){};
#pragma unroll
    for (int d0 = 0; d0 < 8; ++d0) { const int cb = (d0 * 16 + hi * 8) * 2;
        const bf16x8 b0 = *(const LAS bf16x8*)(Ks + KSWZ(r32, cb));
        const bf16x8 b1 = *(const LAS bf16x8*)(Ks + KSWZ(32 + r32, cb));
        p0 = __builtin_amdgcn_mfma_f32_32x32x16_bf16(b0, qr[d0], p0, 0, 0, 0);
        p1 = __builtin_amdgcn_mfma_f32_32x32x16_bf16(b1, qr[d0], p1, 0, 0, 0); }
}
template <int D0> __device__ __forceinline__ void pv_one(f32x16& od, int vb, bf16x8 pa0, bf16x8 pa1, bf16x8 pa2, bf16x8 pa3) {
    const s16x4 l0 = tr_read<v_rd_off(D0, 0, 0)>(vb), h0 = tr_read<v_rd_off(D0, 0, 1)>(vb), l1 = tr_read<v_rd_off(D0, 1, 0)>(vb), h1 = tr_read<v_rd_off(D0, 1, 1)>(vb);
    const s16x4 l2 = tr_read<v_rd_off(D0, 2, 0)>(vb), h2 = tr_read<v_rd_off(D0, 2, 1)>(vb), l3 = tr_read<v_rd_off(D0, 3, 0)>(vb), h3 = tr_read<v_rd_off(D0, 3, 1)>(vb);
    asm volatile("s_waitcnt lgkmcnt(0)" ::: "memory"); SBAR();
#define PK(L, H) (bf16x8){L[0], L[1], L[2], L[3], H[0], H[1], H[2], H[3]}
    od = __builtin_amdgcn_mfma_f32_32x32x16_bf16(PK(l0, h0), pa0, od, 0, 0, 0);
    od = __builtin_amdgcn_mfma_f32_32x32x16_bf16(PK(l1, h1), pa1, od, 0, 0, 0);
    od = __builtin_amdgcn_mfma_f32_32x32x16_bf16(PK(l2, h2), pa2, od, 0, 0, 0);
    od = __builtin_amdgcn_mfma_f32_32x32x16_bf16(PK(l3, h3), pa3, od, 0, 0, 0);
#undef PK
}
template <int D0, int HH> __device__ __forceinline__ void pv_half(f32x16& od, int vb, bf16x8 pa0, bf16x8 pa1) {
    const s16x4 l0 = tr_read<v_rd_off(D0, 2 * HH, 0)>(vb), h0 = tr_read<v_rd_off(D0, 2 * HH, 1)>(vb), l1 = tr_read<v_rd_off(D0, 2 * HH + 1, 0)>(vb), h1 = tr_read<v_rd_off(D0, 2 * HH + 1, 1)>(vb);
    asm volatile("s_waitcnt lgkmcnt(0)" ::: "memory"); SBAR();
#define PK(L, H) (bf16x8){L[0], L[1], L[2], L[3], H[0], H[1], H[2], H[3]}
    od = __builtin_amdgcn_mfma_f32_32x32x16_bf16(PK(l0, h0), pa0, od, 0, 0, 0);
    od = __builtin_amdgcn_mfma_f32_32x32x16_bf16(PK(l1, h1), pa1, od, 0, 0, 0);
#undef PK
}
template <bool MASK, int HH> __device__ __forceinline__ void half_step(f32x16 (&oT)[4], float& lsum, const LAS unsigned char* Ks, int vb, const bf16x8 (&qr)[8], float qterm, float sl2, int qrel, int r32, int hi) {
    f32x16 p = (f32x16){};
#pragma unroll
    for (int d0 = 0; d0 < 8; ++d0) { const int cb = (d0 * 16 + hi * 8) * 2;
        const bf16x8 b0 = *(const LAS bf16x8*)(Ks + KSWZ(32 * HH + r32, cb));
        p = __builtin_amdgcn_mfma_f32_32x32x16_bf16(b0, qr[d0], p, 0, 0, 0); }
    const float base = qterm + sl2 * (float)(4 * hi + 32 * HH);
    float ps = 0.f;
#pragma unroll
    for (int r = 0; r < 16; ++r) { const int kk = (r & 3) + 8 * (r >> 2);
        float a0 = fmaf(p[r], CS, fmaf(sl2, (float)kk, base));
        if (MASK) { const unsigned m0_ = (unsigned)((qrel - (kk + 4 * hi + 32 * HH)) >> 31);
            a0 = __uint_as_float((__float_as_uint(a0) & ~m0_) | (0xff800000u & m0_)); }
        p[r] = __builtin_amdgcn_exp2f(a0); ps += p[r]; }
    lsum += ps;
    bf16x8 pa0, pa1;
#define PK4(P, BASE, OUT) do { unsigned a0_ = cvtpk(P[BASE + 0], P[BASE + 1]), a1_ = cvtpk(P[BASE + 2], P[BASE + 3]);   \
    unsigned b0_ = cvtpk(P[BASE + 4], P[BASE + 5]), b1_ = cvtpk(P[BASE + 6], P[BASE + 7]);                              \
    auto r0_ = __builtin_amdgcn_permlane32_swap(a0_, b0_, false, false); auto r1_ = __builtin_amdgcn_permlane32_swap(a1_, b1_, false, false); \
    v4u w_ = {r0_[0], r1_[0], r0_[1], r1_[1]}; OUT = __builtin_bit_cast(bf16x8, w_); } while (0)
    PK4(p, 0, pa0); PK4(p, 8, pa1);
#undef PK4
    pv_half<0, HH>(oT[0], vb, pa0, pa1); pv_half<1, HH>(oT[1], vb, pa0, pa1); pv_half<2, HH>(oT[2], vb, pa0, pa1); pv_half<3, HH>(oT[3], vb, pa0, pa1);
}
template <bool MASK> __device__ __forceinline__ void tile_step(f32x16 (&oT)[4], float& lsum, const LAS unsigned char* Ks, int vb, const bf16x8 (&qr)[8], float qterm, float sl2, int qrel, int r32, int hi) {
    half_step<MASK, 0>(oT, lsum, Ks, vb, qr, qterm, sl2, qrel, r32, hi);
    half_step<MASK, 1>(oT, lsum, Ks, vb, qr, qterm, sl2, qrel, r32, hi);
}
struct Stg { v4u k0, k1, v0, v1; };
__device__ __forceinline__ void stage_load(Stg& s, const bf16* Kg, const bf16* Vg, size_t krow0, int hc, int tid) {
    const int sr = tid >> 4, sc = (tid & 15) * 8;
    const size_t o0 = (krow0 + sr) * DM + hc + sc, o1 = (krow0 + 32 + sr) * DM + hc + sc;
    s.k0 = *(const GAS v4u*)(Kg + o0); s.k1 = *(const GAS v4u*)(Kg + o1); s.v0 = *(const GAS v4u*)(Vg + o0); s.v1 = *(const GAS v4u*)(Vg + o1);
}
__device__ __forceinline__ void stage_write(const Stg& s, LAS unsigned char* Kb, LAS unsigned char* Vb, int tid) {
    const int sr = tid >> 4, sc = (tid & 15) * 8;
    *(LAS v4u*)(Kb + KSWZ(sr, sc * 2)) = s.k0; *(LAS v4u*)(Kb + KSWZ(32 + sr, sc * 2)) = s.k1;
    *(LAS v4u*)(Vb + v_st(sr, sc)) = s.v0; *(LAS v4u*)(Vb + v_st(32 + sr, sc)) = s.v1;
}
__device__ __forceinline__ void block_stage_issue(Stg (&s)[4], const bf16* Kg, const bf16* Vg, size_t krow0, int hc, int tid) {
    asm volatile("" : "+v"(tid));
#pragma unroll
    for (int t = 0; t < 4; ++t) stage_load(s[t], Kg, Vg, krow0 + 64 * t, hc, tid);
}
__device__ __forceinline__ void block_stage_finish(const Stg (&s)[4], LAS unsigned char* lds, int tid) {
    asm volatile("" : "+v"(tid));
#pragma unroll
    for (int t = 0; t < 4; ++t) stage_write(s[t], lds + LDS_K + t * KT, lds + LDS_V + t * KT, tid);
    LDS_WAIT(); __syncthreads();
}
__device__ __forceinline__ void block_stage(const bf16* Kg, const bf16* Vg, size_t krow0, int hc, LAS unsigned char* lds, int tid) {
    Stg s[4]; block_stage_issue(s, Kg, Vg, krow0, hc, tid); block_stage_finish(s, lds, tid);
}
template <bool CAUSAL> __device__ __forceinline__ void block_tiles(f32x16 (&oT)[4], float& lsum, const bf16x8 (&qr)[8], int t_minus_kb, int qin, int ntile_w, float sl2, float mref2,
                                                                 LAS unsigned char* lds, int r32, int hi, int lane) {
    const int vb0 = (int)(unsigned)(uintptr_t)(lds + LDS_V) + v_rd_base(lane);
#pragma unroll 1
    for (int t = 0; t < ntile_w; ++t) {
        const float qterm = -sl2 * (float)(t_minus_kb - 64 * t) - mref2;
        tile_step<CAUSAL>(oT, lsum, lds + LDS_K + t * KT, vb0 + t * KT, qr, qterm, sl2, qin - 64 * t, r32, hi);
    }
}
__device__ __forceinline__ v4u pair16(u32x2v a  , u32x2v b  ) {
    const auto rx = __builtin_amdgcn_permlane32_swap(a.x, b.x, false, false); const auto ry = __builtin_amdgcn_permlane32_swap(a.y, b.y, false, false);
    return (v4u){rx[0], ry[0], rx[1], ry[1]};
}
__device__ __forceinline__ void unpair16(v4u w, u32x2v& a  , u32x2v& b  ) {
    const auto rx = __builtin_amdgcn_permlane32_swap(w.x, w.z, false, false); const auto ry = __builtin_amdgcn_permlane32_swap(w.y, w.w, false, false);
    a.x = rx[0]; a.y = ry[0]; b.x = rx[1]; b.y = ry[1];
}
template <int CTRL> __device__ __forceinline__ unsigned qdpp(unsigned v) { return (unsigned)__builtin_amdgcn_update_dpp(0, (int)v, CTRL, 0xF, 0xF, true); }
__device__ __forceinline__ void quad_t4(v4u& x0, v4u& x1, v4u& x2, v4u& x3, int lane) {
    asm volatile("" : "+v"(lane));
    const bool o1 = (lane & 1) != 0, o2 = (lane & 2) != 0;
#pragma unroll
    for (int c = 0; c < 4; ++c) {
        { const unsigned a = x0[c], b = x1[c], ta = qdpp<0xB1>(b), tb = qdpp<0xB1>(a); x0[c] = o1 ? ta : a; x1[c] = o1 ? b : tb; }
        { const unsigned a = x2[c], b = x3[c], ta = qdpp<0xB1>(b), tb = qdpp<0xB1>(a); x2[c] = o1 ? ta : a; x3[c] = o1 ? b : tb; }
        { const unsigned a = x0[c], b = x2[c], ta = qdpp<0x4E>(b), tb = qdpp<0x4E>(a); x0[c] = o2 ? ta : a; x2[c] = o2 ? b : tb; }
        { const unsigned a = x1[c], b = x3[c], ta = qdpp<0x4E>(b), tb = qdpp<0x4E>(a); x1[c] = o2 ? ta : a; x3[c] = o2 ? b : tb; }
    }
}
template <int JJ> __device__ __forceinline__ const bf16* quad_ptr(const bf16* p) {
    const unsigned long long u = (unsigned long long)(uintptr_t)p;
    const unsigned lo = qdpp<JJ * 0x55>((unsigned)u), hi = qdpp<JJ * 0x55>((unsigned)(u >> 32));
    return (const bf16*)(uintptr_t)(((unsigned long long)hi << 32) | lo);
}
__device__ __forceinline__ void rows_gather_issue(v4u (&x)[8], const bf16* myrowp, int ok, int lane) {
    asm volatile("" : "+v"(lane));
    const int c0 = (2 * (lane & 3) + (lane >> 5)) * 8;
    const bf16* p0 = quad_ptr<0>(myrowp); const bf16* p1 = quad_ptr<1>(myrowp); const bf16* p2 = quad_ptr<2>(myrowp); const bf16* p3 = quad_ptr<3>(myrowp);
    const int k0 = (int)qdpp<0x00>((unsigned)ok), k1 = (int)qdpp<0x55>((unsigned)ok), k2 = (int)qdpp<0xAA>((unsigned)ok), k3 = (int)qdpp<0xFF>((unsigned)ok);
    const v4u z = (v4u){0u, 0u, 0u, 0u};
    x[0] = k0 ? *(const GAS v4u*)(p0 + c0) : z; x[1] = k1 ? *(const GAS v4u*)(p1 + c0) : z; x[2] = k2 ? *(const GAS v4u*)(p2 + c0) : z; x[3] = k3 ? *(const GAS v4u*)(p3 + c0) : z;
    x[4] = k0 ? *(const GAS v4u*)(p0 + 64 + c0) : z; x[5] = k1 ? *(const GAS v4u*)(p1 + 64 + c0) : z; x[6] = k2 ? *(const GAS v4u*)(p2 + 64 + c0) : z; x[7] = k3 ? *(const GAS v4u*)(p3 + 64 + c0) : z;
}
__device__ __forceinline__ void rows_gather_finish(v4u (&x)[8], int lane) { quad_t4(x[0], x[1], x[2], x[3], lane); quad_t4(x[4], x[5], x[6], x[7], lane); }
__device__ __forceinline__ void rows_scatter(v4u (&x)[8], bf16* myrowp, int ok, int lane) {
    asm volatile("" : "+v"(lane));
    quad_t4(x[0], x[1], x[2], x[3], lane); quad_t4(x[4], x[5], x[6], x[7], lane);
    const int c0 = (2 * (lane & 3) + (lane >> 5)) * 8;
    bf16* p0 = (bf16*)quad_ptr<0>(myrowp); bf16* p1 = (bf16*)quad_ptr<1>(myrowp); bf16* p2 = (bf16*)quad_ptr<2>(myrowp); bf16* p3 = (bf16*)quad_ptr<3>(myrowp);
    const int k0 = (int)qdpp<0x00>((unsigned)ok), k1 = (int)qdpp<0x55>((unsigned)ok), k2 = (int)qdpp<0xAA>((unsigned)ok), k3 = (int)qdpp<0xFF>((unsigned)ok);
    if (k0) { *(GAS v4u*)(p0 + c0) = x[0]; *(GAS v4u*)(p0 + 64 + c0) = x[4]; }
    if (k1) { *(GAS v4u*)(p1 + c0) = x[1]; *(GAS v4u*)(p1 + 64 + c0) = x[5]; }
    if (k2) { *(GAS v4u*)(p2 + c0) = x[2]; *(GAS v4u*)(p2 + 64 + c0) = x[6]; }
    if (k3) { *(GAS v4u*)(p3 + c0) = x[3]; *(GAS v4u*)(p3 + 64 + c0) = x[7]; }
}
#define INS3(v, n) do { const bool a_ = (v) > v0, b_ = (v) > v1, c_ = (v) > v2; \
    v2 = b_ ? v1 : (c_ ? (v) : v2); n2 = b_ ? n1 : (c_ ? (n) : n2); v1 = a_ ? v0 : (b_ ? (v) : v1); n1 = a_ ? n0 : (b_ ? (n) : n1); v0 = a_ ? (v) : v0; n0 = a_ ? (n) : n0; } while (0)
__device__ __forceinline__ void gate_unit(int b, int h, int i, const bf16* Q, const float* KMP, unsigned* SEL, LAS unsigned char* lds, int tid) {
    const int lane = tid & 63, wid = __builtin_amdgcn_readfirstlane(tid >> 6), r32 = lane & 31, hi = lane >> 5;
    unsigned* selp = SEL + ((size_t)(b * NH + h) * SEQ + i * BLK + wid * 32 + r32);
    if (i == 0) { if (hi == 0) *selp = 0x00ffffffu; return; }
    bf16x8 qr[8];
    v4u qv[8]; rows_gather_issue(qv, Q + (size_t)(b * SEQ + i * BLK + wid * 32 + r32) * DM + h * HD, 1, lane);
    {
        const float* kb = KMP + ((size_t)(b * NH + h) * NBLK) * 2 * HD;
        f32x4 kv[8];
#pragma unroll
        for (int k = 0; k < 8; ++k) { const int n = wid + 8 * k;
            kv[k] = (n < i) ? *(const GAS f32x4*)(kb + (size_t)n * 2 * HD + lane * 4) : (f32x4){0.f, 0.f, 0.f, 0.f}; }
        rows_gather_finish(qv, lane);
#pragma unroll
        for (int d0 = 0; d0 < 8; ++d0) qr[d0] = __builtin_bit_cast(bf16x8, qv[d0]);
#pragma unroll
        for (int k = 0; k < 8; ++k) { const int n = wid + 8 * k, chunk = lane & 31;
            float hv[4];
#pragma unroll
            for (int e = 0; e < 4; ++e) { const float m = kv[k][e] + __shfl_xor(kv[k][e], 32); const float hb = __uint_as_float(f2bf(m) << 16); hv[e] = (lane < 32) ? hb : (m - hb); }
            u32x2v w; w.x = pk2(hv[0], hv[1]); w.y = pk2(hv[2], hv[3]);
            *(LAS u32x2v*)(lds + (lane < 32 ? 0 : KT) + n * 256 + ((((chunk >> 1) << 4) ^ ((n & 7) << 4)) + ((chunk & 1) << 3))) = w; }
    }
    LDS_WAIT(); __syncthreads();
    f32x16 g0, g1, l0, l1;
    qkt(g0, g1, lds, qr, r32, hi); qkt(l0, l1, lds + KT, qr, r32, hi);
    float v0 = -INFINITY, v1 = -INFINITY, v2 = -INFINITY; int n0 = 255, n1 = 255, n2 = 255;
#pragma unroll
    for (int r = 0; r < 16; ++r) { const int n = crow(r, hi); const float g = (n < i) ? g0[r] + l0[r] : -INFINITY; INS3(g, n); }
#pragma unroll
    for (int r = 0; r < 16; ++r) { const int n = 32 + crow(r, hi); const float g = (n < i) ? g1[r] + l1[r] : -INFINITY; INS3(g, n); }
    {
        const float pv0 = __shfl_xor(v0, 32), pv1 = __shfl_xor(v1, 32), pv2 = __shfl_xor(v2, 32);
        const int pn0 = __shfl_xor(n0, 32), pn1 = __shfl_xor(n1, 32), pn2 = __shfl_xor(n2, 32);
        INS3(pv0, pn0); INS3(pv1, pn1); INS3(pv2, pn2);
    }
    if (hi == 0) *selp = (unsigned)n0 | ((unsigned)n1 << 8) | ((unsigned)n2 << 16);
    __syncthreads();
}
#undef INS3
__device__ __forceinline__ int zero_dist(float sl2) { const float d = 160.0f / sl2; return d > 1.0e6f ? 1000000 : (int)d; }
__device__ __forceinline__ void sel_unit(int b, int h, int j, const bf16* Q, const bf16* K, const bf16* V, const unsigned* SEL, bf16* PO0, bf16* PO1, bf16* PO2, float* LS,
                                         float sl2, float mref2, LAS unsigned char* lds, int tid) {
    const int lane = tid & 63, wid = __builtin_amdgcn_readfirstlane(tid >> 6), r32 = lane & 31, hi = lane >> 5;
    LAS unsigned* cnt = (LAS unsigned*)(lds + LDS_CNT);
    LAS unsigned short* list = (LAS unsigned short*)(lds + LDS_LIST);
    const unsigned* selp = SEL + (size_t)(b * NH + h) * SEQ;
    const int s_first = BLK * (j + 1);
    const int s_last = BLK * j + (BLK - 1) + zero_dist(sl2);
    const int s_end = s_last + 1 < SEQ ? ((s_last + 1 + 255) & ~255) : SEQ;
    if (s_first >= s_end) return;
    bool staged = false;
    for (int s0 = s_first; s0 < s_end; s0 += LIST_CAP) {
        if (tid == 0) *cnt = 0u;
        LDS_WAIT(); __syncthreads();
        const int nscan = (s_end - s0) < LIST_CAP ? (s_end - s0) : LIST_CAP;
        v4u ev[LIST_CAP / 2048];
#pragma unroll
        for (int k = 0; k < LIST_CAP / 2048; ++k) { const int o = k * 2048 + tid * 4; ev[k] = (o < nscan) ? *(const GAS v4u*)(selp + s0 + o) : (v4u){~0u, ~0u, ~0u, ~0u}; }
#pragma unroll
        for (int k = 0; k < LIST_CAP / 2048; ++k) {
            if (k * 2048 < nscan) {
#pragma unroll
                for (int c = 0; c < 4; ++c) {
                    const unsigned e = ev[k][c]; const int s = s0 + k * 2048 + tid * 4 + c;
                    int slot = ((e & 255u) == (unsigned)j) ? 0 : ((((e >> 8) & 255u) == (unsigned)j) ? 1 : ((((e >> 16) & 255u) == (unsigned)j) ? 2 : -1));
                    if (s > s_last) slot = -1;
                    const unsigned long long mask = __ballot(slot >= 0);
                    if (mask) {
                        unsigned base_pos = 0;
                        if (lane == 0) base_pos = __hip_atomic_fetch_add(cnt, (unsigned)__popcll(mask), __ATOMIC_RELAXED, __HIP_MEMORY_SCOPE_WORKGROUP);
                        base_pos = __builtin_amdgcn_readfirstlane(base_pos);
                        if (slot >= 0) { const unsigned pos = base_pos + __builtin_amdgcn_mbcnt_hi((unsigned)(mask >> 32), __builtin_amdgcn_mbcnt_lo((unsigned)mask, 0u)); list[pos] = (unsigned short)(s | (slot << 14)); }
                    }
                }
            }
        }
        LDS_WAIT(); __syncthreads();
        const int L = (int)*cnt;
        v4u qn[8]; unsigned entn = 0u;
        if (wid * 32 < L) { const int idx = wid * 32 + r32; entn = list[idx < L ? idx : wid * 32];
            rows_gather_issue(qn, Q + ((size_t)b * SEQ + (entn & 0x3fffu)) * DM + h * HD, 1, lane); }
        if (L > 0 && !staged) { block_stage(K, V, (size_t)b * SEQ + (size_t)j * BLK, h * HD, lds, tid); staged = true; }
#pragma unroll 1
        for (int grp = wid; grp * 32 < L; grp += NWAVES) {
            const int valid = (grp * 32 + r32 < L) ? 1 : 0;
            const unsigned ent = entn;
            rows_gather_finish(qn, lane);
            bf16x8 qr[8];
#pragma unroll
            for (int d0 = 0; d0 < 8; ++d0) qr[d0] = __builtin_bit_cast(bf16x8, qn[d0]);
            if ((grp + NWAVES) * 32 < L) { const int idx = (grp + NWAVES) * 32 + r32; entn = list[idx < L ? idx : (grp + NWAVES) * 32];
                rows_gather_issue(qn, Q + ((size_t)b * SEQ + (entn & 0x3fffu)) * DM + h * HD, 1, lane); }
            const int s = ent & 0x3fff, slot = ent >> 14;
            const size_t m = (size_t)b * SEQ + s;
            f32x16 oT[4]; oT[0] = (f32x16){}; oT[1] = (f32x16){}; oT[2] = (f32x16){}; oT[3] = (f32x16){};
            float lsum = 0.f;
            block_tiles<false>(oT, lsum, qr, s - j * BLK, 0, 4, sl2, mref2, lds, r32, hi, lane);
            lsum += __shfl_xor(lsum, 32);
            v4u pc[8];
#pragma unroll
            for (int d0 = 0; d0 < 4; ++d0)
#pragma unroll
                for (int g = 0; g < 4; g += 2) { u32x2v wa, wb; wa.x = cvtpk(oT[d0][4 * g], oT[d0][4 * g + 1]); wa.y = cvtpk(oT[d0][4 * g + 2], oT[d0][4 * g + 3]);
                    wb.x = cvtpk(oT[d0][4 * g + 4], oT[d0][4 * g + 5]); wb.y = cvtpk(oT[d0][4 * g + 6], oT[d0][4 * g + 7]);
                    pc[2 * d0 + g / 2] = pair16(wa, wb); }
            rows_scatter(pc, (slot == 0 ? PO0 : (slot == 1 ? PO1 : PO2)) + m * DM + h * HD, valid, lane);
            if (valid && hi == 0) LS[(m * NH + h) * 4 + slot] = lsum;
        }
        __syncthreads();
    }
}
__device__ __forceinline__ void own_unit(int b, int h, int i, const bf16* Q, const bf16* K, const bf16* V, const bf16* PO0, const bf16* PO1, const bf16* PO2, const float* LS, const unsigned* SEL, bf16* AO,
                                         float sl2, float mref2, LAS unsigned char* lds, int tid, bool do_store = true) {
    const int lane = tid & 63, wid = __builtin_amdgcn_readfirstlane(tid >> 6), r32 = lane & 31, hi = lane >> 5;
    const size_t krow0 = (size_t)b * SEQ + (size_t)i * BLK, m = krow0 + wid * 32 + r32;
    const int nsel = i < 3 ? i : 3;
    const unsigned selw = nsel ? SEL[(size_t)(b * NH + h) * SEQ + i * BLK + wid * 32 + r32] : 0u;
    f32x16 oT[4]; oT[0] = (f32x16){}; oT[1] = (f32x16){}; oT[2] = (f32x16){}; oT[3] = (f32x16){};
    float lsel = 0.f;
    const int zd = zero_dist(sl2), spos = i * BLK + wid * 32 + r32;
#define OWN_KEEP(sl) (spos <= BLK * (int)((selw >> (8 * (sl))) & 255u) + (BLK - 1) + zd)
#define OWN_ACC(pc) do { _Pragma("unroll") for (int d0 = 0; d0 < 4; ++d0) _Pragma("unroll") for (int g = 0; g < 4; g += 2) { u32x2v wa, wb; unpair16(pc[2 * d0 + g / 2], wa, wb); \
        oT[d0][4 * g] += bf_lo(wa.x); oT[d0][4 * g + 1] += bf_hi(wa.x); oT[d0][4 * g + 2] += bf_lo(wa.y); oT[d0][4 * g + 3] += bf_hi(wa.y); \
        oT[d0][4 * g + 4] += bf_lo(wb.x); oT[d0][4 * g + 5] += bf_hi(wb.x); oT[d0][4 * g + 6] += bf_lo(wb.y); oT[d0][4 * g + 7] += bf_hi(wb.y); } } while (0)
    if (nsel > 2) {
        const bool k0 = OWN_KEEP(0), k1 = OWN_KEEP(1), k2 = OWN_KEEP(2);
        v4u pa[8], pb[8], pc[8]; rows_gather_issue(pa, PO0 + m * DM + h * HD, k0 ? 1 : 0, lane); rows_gather_issue(pb, PO1 + m * DM + h * HD, k1 ? 1 : 0, lane); rows_gather_issue(pc, PO2 + m * DM + h * HD, k2 ? 1 : 0, lane);
        if (k0) lsel += LS[(m * NH + h) * 4 + 0];
        if (k1) lsel += LS[(m * NH + h) * 4 + 1];
        if (k2) lsel += LS[(m * NH + h) * 4 + 2];
        rows_gather_finish(pa, lane); OWN_ACC(pa); rows_gather_finish(pb, lane); OWN_ACC(pb); rows_gather_finish(pc, lane); OWN_ACC(pc);
    } else if (nsel == 2) {
        const bool k0 = OWN_KEEP(0), k1 = OWN_KEEP(1);
        v4u pa[8], pb[8]; rows_gather_issue(pa, PO0 + m * DM + h * HD, k0 ? 1 : 0, lane); rows_gather_issue(pb, PO1 + m * DM + h * HD, k1 ? 1 : 0, lane);
        if (k0) lsel += LS[(m * NH + h) * 4 + 0];
        if (k1) lsel += LS[(m * NH + h) * 4 + 1];
        rows_gather_finish(pa, lane); OWN_ACC(pa); rows_gather_finish(pb, lane); OWN_ACC(pb);
    } else if (nsel == 1) {
        const bool k0 = OWN_KEEP(0);
        v4u pa[8]; rows_gather_issue(pa, PO0 + m * DM + h * HD, k0 ? 1 : 0, lane);
        if (k0) lsel += LS[(m * NH + h) * 4 + 0];
        rows_gather_finish(pa, lane); OWN_ACC(pa);
    }
#undef OWN_KEEP
#undef OWN_ACC
    bf16x8 qr[8];
    { v4u qv[8]; rows_gather_issue(qv, Q + m * DM + h * HD, 1, lane);
      Stg kv[4]; block_stage_issue(kv, K, V, krow0, h * HD, tid);
      rows_gather_finish(qv, lane);
#pragma unroll
      for (int d0 = 0; d0 < 8; ++d0) qr[d0] = __builtin_bit_cast(bf16x8, qv[d0]);
      block_stage_finish(kv, lds, tid); }
    float lsum = 0.f;
    int qin = wid * 32 + r32; asm volatile("" : "+v"(qin));
    block_tiles<true>(oT, lsum, qr, qin, qin, (wid >> 1) + 1, sl2, mref2, lds, r32, hi, lane);
    lsum += __shfl_xor(lsum, 32);
    lsum += lsel;
    const float rl = 1.0f / lsum;
    { v4u pc[8];
#pragma unroll
      for (int d0 = 0; d0 < 4; ++d0)
#pragma unroll
          for (int g = 0; g < 4; g += 2) { u32x2v wa, wb; wa.x = cvtpk(oT[d0][4 * g] * rl, oT[d0][4 * g + 1] * rl); wa.y = cvtpk(oT[d0][4 * g + 2] * rl, oT[d0][4 * g + 3] * rl);
              wb.x = cvtpk(oT[d0][4 * g + 4] * rl, oT[d0][4 * g + 5] * rl); wb.y = cvtpk(oT[d0][4 * g + 6] * rl, oT[d0][4 * g + 7] * rl);
              pc[2 * d0 + g / 2] = pair16(wa, wb); }
      rows_scatter(pc, AO + m * DM + h * HD, do_store ? 1 : 0, lane); }
    __syncthreads();
}
}

__device__ __forceinline__ void group_barrier(gu32* word, unsigned target) {
    asm volatile("s_waitcnt vmcnt(0)" ::: "memory");
    __syncthreads();
    if (threadIdx.x == 0) {
        __builtin_amdgcn_fence(__ATOMIC_RELEASE, "agent");
        asm volatile("s_waitcnt vmcnt(0)" ::: "memory");
        (void)__hip_atomic_fetch_add(word, 1u, __ATOMIC_RELAXED, __HIP_MEMORY_SCOPE_AGENT);
        unsigned sp = 0u;
        while (__hip_atomic_load(word, __ATOMIC_RELAXED, __HIP_MEMORY_SCOPE_AGENT) < target) { __builtin_amdgcn_s_sleep(1); if (++sp > (1u << 22)) break; }
        __builtin_amdgcn_fence(__ATOMIC_ACQUIRE, "agent");
        asm volatile("s_waitcnt vmcnt(0)" ::: "memory");
    }
    __syncthreads();
}
struct Args { const float* in[15]; float* out; unsigned char* ws; int pad0, pad1; };
__global__ void __launch_bounds__(NWAVES * 64, 2) fwd(Args args) {
    extern __shared__ __attribute__((aligned(16))) unsigned char lds_raw[];
    LAS unsigned char* lds = (LAS unsigned char*)lds_raw;
    volatile LAS unsigned* MISC = (volatile LAS unsigned*)(lds + MISC_OFF);
    const int tid = threadIdx.x, lane = tid & 63, wave = __builtin_amdgcn_readfirstlane(tid >> 6);
    const int G = gridDim.x, bx = blockIdx.x;
    const int vcu = (G % 8 == 0) ? (bx % 8) * (G / 8) + bx / 8 : bx;
    const int gw = vcu * NWAVES + wave, NGW = G * NWAVES;
    unsigned char* ws = args.ws;
    gu32* ctl = (gu32*)(ws + WS_CTL);
    const float* x = args.in[0]; const float* mix_norm = args.in[1]; const float* ffn_norm = args.in[2]; const float* w_in = args.in[3]; const float* conv_w = args.in[4];
    const float* sgu_gain = args.in[5]; const float* w_s = args.in[6]; const float* b_s = args.in[7]; const float* w_mix_out = args.in[8]; const float* w_qkv = args.in[9];
    const float* q_gain = args.in[10]; const float* k_gain = args.in[11]; const float* w_attn_out = args.in[12]; const float* w_up = args.in[13]; const float* w_down = args.in[14];
    float* out = args.out;
    bf16* WIN = (bf16*)(ws + WS_WIN); bf16* WOUT = (bf16*)(ws + WS_WOUT); bf16* WUP0 = (bf16*)(ws + WS_WUP0); bf16* WDN0 = (bf16*)(ws + WS_WDN0);
    bf16* WQKV = (bf16*)(ws + WS_WQKV); bf16* WO = (bf16*)(ws + WS_WO); bf16* WUP1 = (bf16*)(ws + WS_WUP1); bf16* WDN1 = (bf16*)(ws + WS_WDN1);
    bf16* XB = (bf16*)(ws + WS_HB); bf16* Z = (bf16*)(ws + WS_Z); bf16* CAT = (bf16*)(ws + WS_CAT); bf16* HID = (bf16*)(ws + WS_HID);
    bf16* QB = (bf16*)(ws + WS_Q); bf16* KB = (bf16*)(ws + WS_K); bf16* VB = (bf16*)(ws + WS_V);
    bf16* PO0 = (bf16*)(ws + WS_PO0); bf16* PO1 = (bf16*)(ws + WS_PO1); bf16* PO2 = (bf16*)out;
    bf16* WSB = (bf16*)(ws + WS_WSB); float* KMP = (float*)(ws + WS_KMP); unsigned* SEL = (unsigned*)(ws + WS_SEL); float* LS = (float*)(ws + WS_LS); float* RSS = (float*)(ws + WS_RSS);
    LAS float* RINV = (LAS float*)(lds + RINV_OFF);
    signed char* XQ = (signed char*)(ws + WS_XQ); signed char* WQ0 = (signed char*)(ws + WS_WUP0); signed char* WQ1 = (signed char*)(ws + WS_WUP1); float* ROWS = (float*)(ws + WS_ROWS); unsigned* CMAX = (unsigned*)(ws + WS_CMAX); unsigned* CMAXIN = (unsigned*)(ws + WS_CMAX_IN); unsigned* CMAXO = (unsigned*)(ws + WS_CMAX_O); unsigned* CMAXQ = (unsigned*)(ws + WS_CMAX_QKV); signed char* WQQ = (signed char*)(ws + WS_WQKV); signed char* WQO = (signed char*)(ws + WS_WO); signed char* WQIN = (signed char*)(ws + WS_WQKV + 12 * MiB); unsigned* CMAXD = (unsigned*)(ws + WS_CMAX_DN); int* CSUMD = (int*)(ws + WS_CSUM_DN); signed char* WQD0 = (signed char*)(ws + WS_WDN0); signed char* WQD1 = (signed char*)(ws + WS_WDN1); float* HROWS = (float*)(ws + WS_HROWS);

    for (int u = tid; u < (LDS_BYTES - LDSCTL_OFF) / 4; u += NWAVES * 64) ((LAS unsigned*)(lds + LDSCTL_OFF))[u] = 0u;
    __syncthreads();
    const XcdBarrier bar = xcd_barrier_post((unsigned*)(ctl + CW_BAR), MISC + 8);
#ifndef REPEAT_MASK
#define REPEAT_MASK 0
#endif
#define PH(k) for (int rep_ = 0; rep_ < 1 + (((REPEAT_MASK) >> (k)) & 1); ++rep_)
#define NORM_ORDER(S, N_) pg8::NormOrder S; S.init(M, N_, G, bx); S.rss = RSS; S.tab = RINV; S.inv_n = 1.0f / DM; S.eps = EPS

    PH(0) {
        LAS unsigned char* scr = lds + RING_OFF + wave * 16384;
        constexpr int I_IN = (DM / 64) * (NMIX / 64), I_SQ = (DM / 64) * (DM / 64), I_UP = (DM / 64) * (DFF / 64), I_DN = (DFF / 64) * (DM / 64), I_QKV = (DM / 64) * (NQKV / 64);
        constexpr int I_UV = (DM / 64) * (2 * CW / 64); constexpr int NITEMS = I_IN + 2 * I_SQ + 2 * I_UP + 2 * I_DN + I_QKV + I_UV;
        for (int it = gw; it < NITEMS; it += NGW) {
            int r = it;
            if (r < I_IN) { p0_transpose_item(w_in, DM, NMIX, WIN, scr, r, lane, mix_norm); continue; } r -= I_IN;
            if (r < I_SQ) { p0_transpose_item(w_mix_out, DM, DM, WOUT, scr, r, lane, nullptr); continue; } r -= I_SQ;
            if (r < I_UP) { up_absmax_item(w_up, DM, DFF, CMAX, r, lane, ffn_norm); continue; } r -= I_UP;
            if (r < I_DN) { up_absmax_item(w_down, DFF, DM, CMAXD, r, lane, nullptr); continue; } r -= I_DN;
            if (r < I_QKV) { up_absmax_item(w_qkv, DM, NQKV, CMAXQ, r, lane, mix_norm + DM); continue; } r -= I_QKV;
            if (r < I_SQ) { up_absmax_item(w_attn_out, DM, DM, CMAXO, r, lane, nullptr); continue; } r -= I_SQ;
            if (r < I_UP) { up_absmax_item(w_up + (size_t)DM * DFF, DM, DFF, CMAX + DFF, r, lane, ffn_norm + DM); continue; } r -= I_UP;
            if (r < I_DN) { up_absmax_item(w_down + (size_t)DFF * DM, DFF, DM, CMAXD + DM, r, lane, nullptr); continue; } r -= I_DN;
            up_absmax_item(w_in + 3 * CW, DM, 2 * CW, CMAXIN, r, lane, mix_norm, NMIX);
        }
        for (int e = (bx * NWAVES * 64 + tid) * 4; e < SGG * 128 * 128; e += G * NWAVES * 64 * 4) {
            const int i = (e >> 7) & 127, j = e & 127; const f32x4 v = *(const GAS f32x4*)(w_s + e);
            u32x2v w; w.x = pk2(j <= i ? v.x : 0.f, j + 1 <= i ? v.y : 0.f); w.y = pk2(j + 2 <= i ? v.z : 0.f, j + 3 <= i ? v.w : 0.f);
            *(GAS u32x2v*)(WSB + e) = w;
        }
        xb_rows(x, XB, RSS, XQ, ROWS, gw, NGW, lane);
    }
    xcd_barrier(bar);
    {
        LAS unsigned char* scr = lds + RING_OFF + wave * 16384;
        constexpr int I_INQ = (DM / 64) * (NMIX / 64);
        constexpr int I_UVQ = (DM / 64) * (2 * CW / 64);
        for (int it = gw; it < I_UVQ; it += NGW) up_quant_item(w_in + 3 * CW, DM, 2 * CW, WQIN, (const float*)CMAXIN, scr, it, lane, mix_norm, nullptr, NMIX);
        constexpr int I_DQ = (DFF / 64) * (DM / 64);
        for (int it = gw; it < 2 * I_DQ; it += NGW) { const int l = it >= I_DQ ? 1 : 0;
            up_quant_item(w_down + (size_t)l * DFF * DM, DFF, DM, l ? WQD1 : WQD0, (const float*)CMAXD + l * DM, scr, it - l * I_DQ, lane, nullptr, CSUMD + l * DM); }
        constexpr int I_QQ = (DM / 64) * (NQKV / 64);
        for (int it = gw; it < I_QQ; it += NGW) up_quant_item(w_qkv, DM, NQKV, WQQ, (const float*)CMAXQ, scr, it, lane, mix_norm + DM);
        constexpr int I_OQ = (DM / 64) * (DM / 64);
        for (int it = gw; it < I_OQ; it += NGW) up_quant_item(w_attn_out, DM, DM, WQO, (const float*)CMAXO, scr, it, lane, nullptr);
    }
    xcd_barrier(bar);
    PH(1) {
        { pg8::Gemm g{XB, WIN, M, 3 * CW, DM}; NORM_ORDER(S, 3 * CW);
          pg8::EpiActR<1> E{Z, NMIX, 0, 0, RINV, 1 << 20};
          pg8::gemm_phase<pg8::EpiActR<1>, pg8::NormOrder, PG8_ALIGN, PG8_SP2>(lds + RING_OFF, g, S, E); }
        { pg8::Gemm g{(const bf16*)XQ, (const bf16*)WQIN, M, 2 * CW, DM / 2};
          pg8::ScaleOrder S; S.init(M, 2 * CW, G, bx); S.rows = ROWS; S.tab = RINV;
          pg8::EpiActR<1, 0, false, true> E{Z + 3 * CW, NMIX, 0, 0, RINV, 0, (const float*)CMAXIN};
          pg8::gemm_phase<pg8::EpiActR<1, 0, false, true>, pg8::ScaleOrder, PG8_ALIGN, PG8_SP2>(lds + RING_OFF, g, S, E); }
    }
    xcd_barrier(bar);
    PH(2) { for (int u = vcu; u < M / SGC; u += G) mixer_unit(u, Z, CAT, conv_w, sgu_gain, WSB, b_s, lds + RING_OFF, tid); }
    xcd_barrier(bar);
    {
        pg8::Gemm g{CAT, WOUT, M, DM, DM}; pg8::StaticOrder S; S.init(M, DM, G, bx);
        pg8::EpiResB<false> E{XB, DM, nullptr, 0, RSS};
        pg8::gemm_phase<pg8::EpiResB<false>, pg8::StaticOrder, PG8_ALIGN, PG8_SP2>(lds + RING_OFF, g, S, E);
    }
    xcd_barrier(bar);
    {
        LAS unsigned char* scr = lds + RING_OFF + wave * 16384;
        constexpr int I_UPQ = (DM / 64) * (DFF / 64);
        for (int it = gw; it < 2 * I_UPQ; it += NGW) { const int l = it >= I_UPQ ? 1 : 0;
            up_quant_item(w_up + (size_t)l * DM * DFF, DM, DFF, l ? WQ1 : WQ0, (const float*)CMAX + l * DFF, scr, it - l * I_UPQ, lane, ffn_norm + l * DM); }
        xq_rows<true>(XB, XQ, ROWS, gw, NGW, lane);
    }
    xcd_barrier(bar);
    {
        const int grp = bx & 7, lw = (bx >> 3) * NWAVES + wave;
        gu32* gbw = ctl + CW_GBAR + 64 * grp;
#pragma unroll 1
        for (int sl = 0; sl < 4; ++sl) {
            { pg8::Gemm g{(const bf16*)XQ, (const bf16*)WQ0, M, DFF, DM / 2};
              pg8::ScaleOrder S; S.init(M, DFF, G, bx); S.i0 = 4 * sl; S.ilim = 4; S.rows = ROWS; S.tab = RINV;
              pg8::EpiActR<2, 0, true, true> E{HID, DFF, 0, 0, RINV, 0, (const float*)CMAX};
              pg8::gemm_phase<pg8::EpiActR<2, 0, true, true>, pg8::ScaleOrder, PG8_ALIGN, PG8_SP2>(lds + RING_OFF, g, S, E); }
            group_barrier(gbw, 32u * (unsigned)(sl + 1));
            hq_rows(HID, HROWS, (16 * grp + 4 * sl) * BLK, 4 * BLK, lw, 32 * NWAVES, lane);
        }
        group_barrier(gbw, 32u * 5u);
    }
    {
        pg8::Gemm g{HID, (const bf16*)WQD0, M, DM, DFF / 2, 2}; pg8::ScaleOrder S; S.init(M, DM, G, bx); S.rows = HROWS; S.tab = RINV;
        pg8::EpiResB<false, true, true> E{XB, DM, nullptr, 0, RSS, RINV, (const float*)CMAXD, CSUMD};
        pg8::gemm_phase<pg8::EpiResB<false, true, true>, pg8::ScaleOrder, PG8_ALIGN, PG8_SP2>(lds + RING_OFF, g, S, E);
    }
    xcd_barrier(bar);
    xq_rows<true>(XB, XQ, ROWS, gw, NGW, lane);
    xcd_barrier(bar);
    PH(8) {
        pg8::Gemm g{(const bf16*)XQ, (const bf16*)WQQ, M, NQKV, DM / 2};
        pg8::ScaleOrder S; S.init(M, NQKV, G, bx); S.rows = ROWS; S.tab = RINV;
        static_assert(PG8_ALIGN, "EpiQKV contains a workgroup barrier: both half-workgroups must run their epilogues together");
        pg8::EpiQKVT<true> E{QB, DM, (size_t)M * DM, RINV, (LAS float*)(lds + XCH_OFF), q_gain, k_gain, KMP, EPS, NH, NBLK, (const float*)CMAXQ};
        pg8::gemm_phase<pg8::EpiQKVT<true>, pg8::ScaleOrder, PG8_ALIGN, PG8_SP2>(lds + RING_OFF, g, S, E);
    }
    xcd_barrier(bar);
    float mref2;
    { int l2 = lane; asm volatile("" : "+v"(l2));
      const float gqm = wave_max(fmaxf(fabsf(q_gain[l2]), fabsf(q_gain[l2 + 64]))), gkm = wave_max(fmaxf(fabsf(k_gain[l2]), fabsf(k_gain[l2 + 64])));
      mref2 = 11.313708498984761f * gqm * gkm * att::LOG2E; }
    PH(10) { for (int u = bx; u < NB * NH * NBLK; u += G) { const int bh = u % (NB * NH), i = u / (NB * NH); att::gate_unit(bh / NH, bh % NH, i, QB, KMP, SEL, lds + RING_OFF, tid); } }
    xcd_barrier(bar);
    {
        gu32* selq = ctl + CW_SELQ; volatile LAS unsigned* tkw = MISC + 20;
        if (tid == 0) tkw[0] = __hip_atomic_fetch_add(selq, 1u, RLX_AGENT);
        LDS_WAIT(); __syncthreads();
        unsigned tk = tkw[0];
        __syncthreads();
        while (tk < (unsigned)(NB * NH * NBLK)) {
            unsigned nxt = 0u;
            if (tid == 0) nxt = __hip_atomic_fetch_add(selq, 1u, RLX_AGENT);
            const int j = (int)(tk / (NB * NH)), hb = (int)(tk % (NB * NH)), b = hb & 1, h = (NH - 1) - (hb >> 1);
            const float sl2 = __builtin_amdgcn_exp2f(-0.5f * (float)(h + 1)) * att::LOG2E;
            att::sel_unit(b, h, j, QB, KB, VB, SEL, PO0, PO1, PO2, LS, sl2, mref2, lds + RING_OFF, tid);
            if (tid == 0) tkw[0] = nxt;
            LDS_WAIT(); __syncthreads();
            tk = tkw[0];
            __syncthreads();
        }
    }
    xcd_barrier(bar);
    {
        for (int u = bx; u < NB * NH * NBLK; u += G) { const int bh = u % (NB * NH), i = u / (NB * NH); const int h = bh % NH; const float sl2 = __builtin_amdgcn_exp2f(-0.5f * (float)(h + 1)) * att::LOG2E;
            att::own_unit(bh / NH, h, i, QB, KB, VB, PO0, PO1, PO2, LS, SEL, QB, sl2, mref2, lds + RING_OFF, tid); }
    }
    xcd_barrier(bar);
    xq_rows<false>(QB, XQ, ROWS, gw, NGW, lane);
    xcd_barrier(bar);
    {
        pg8::Gemm g{(const bf16*)XQ, (const bf16*)WQO, M, DM, DM / 2};
        pg8::ScaleOrder S; S.init(M, DM, G, bx); S.rows = ROWS; S.tab = RINV;
        pg8::EpiResB<false, true> E{XB, DM, nullptr, 0, RSS, RINV, (const float*)CMAXO};
        pg8::gemm_phase<pg8::EpiResB<false, true>, pg8::ScaleOrder, PG8_ALIGN, PG8_SP2>(lds + RING_OFF, g, S, E);
    }
    xcd_barrier(bar);
    xq_rows<true>(XB, XQ, ROWS, gw, NGW, lane);
    xcd_barrier(bar);
    {
        const int grp = bx & 7, lw = (bx >> 3) * NWAVES + wave;
        gu32* gbw = ctl + CW_GBAR + 64 * grp;
#pragma unroll 1
        for (int sl = 0; sl < 4; ++sl) {
            { pg8::Gemm g{(const bf16*)XQ, (const bf16*)WQ1, M, DFF, DM / 2};
              pg8::ScaleOrder S; S.init(M, DFF, G, bx); S.i0 = 4 * sl; S.ilim = 4; S.rows = ROWS; S.tab = RINV;
              pg8::EpiActR<2, 0, true, true> E{HID, DFF, 0, 0, RINV, 0, (const float*)CMAX + DFF};
              pg8::gemm_phase<pg8::EpiActR<2, 0, true, true>, pg8::ScaleOrder, PG8_ALIGN, PG8_SP2>(lds + RING_OFF, g, S, E); }
            group_barrier(gbw, 32u * (unsigned)(sl + 6));
            hq_rows(HID, HROWS, (16 * grp + 4 * sl) * BLK, 4 * BLK, lw, 32 * NWAVES, lane);
        }
        group_barrier(gbw, 32u * 10u);
    }
    {
        pg8::Gemm g{HID, (const bf16*)WQD1, M, DM, DFF / 2, 2}; pg8::ScaleOrder S; S.init(M, DM, G, bx); S.rows = HROWS; S.tab = RINV;
        pg8::EpiResB<true, true, true> E{XB, DM, out, DM, nullptr, RINV, (const float*)CMAXD + DM, CSUMD + DM};
        pg8::gemm_phase<pg8::EpiResB<true, true, true>, pg8::ScaleOrder, PG8_ALIGN, PG8_SP2>(lds + RING_OFF, g, S, E);
    }
#undef PH
#undef NORM_ORDER
}

extern "C" void kernel_launch(void* const* d_in, const int* in_sizes, int n_in, void* d_out, int out_size, void* d_ws, size_t ws_size, hipStream_t stream) {
    static int grid = 0;
    if (grid == 0) {
        if (n_in != 15 || in_sizes[0] != M * DM || out_size != M * DM || ws_size < WS_END) {
            fprintf(stderr, "kernel_launch: built for 15 inputs, x/out of %d floats, >= %zu bytes of workspace; got n_in %d, in0 %d, out %d, ws %zu; nothing launched\n", M * DM, (size_t)WS_END, n_in, n_in > 0 ? in_sizes[0] : -1, out_size, ws_size);
            grid = -1; return; }
        int dev = 0, cus = 0, per_cu = 0;
        if (hipGetDevice(&dev) != hipSuccess || hipDeviceGetAttribute(&cus, hipDeviceAttributeMultiprocessorCount, dev) != hipSuccess) { fprintf(stderr, "kernel_launch: device query failed\n"); grid = -1; return; }
        if (hipFuncSetAttribute((const void*)fwd, hipFuncAttributeMaxDynamicSharedMemorySize, LDS_BYTES) != hipSuccess) { fprintf(stderr, "kernel_launch: hipFuncSetAttribute failed\n"); grid = -1; return; }
        if (hipOccupancyMaxActiveBlocksPerMultiprocessor(&per_cu, (const void*)fwd, NWAVES * 64, LDS_BYTES) != hipSuccess || per_cu < 1)
            fprintf(stderr, "kernel_launch: note: occupancy query reports %d workgroups per CU\n", per_cu);
        (void)hipGetLastError();
        grid = cus;
    }
    if (grid < 0) return;
    if (hipMemsetAsync((char*)d_ws + WS_CTL, 0, CTL_ZERO_BYTES, stream) != hipSuccess) { fprintf(stderr, "kernel_launch: memset failed\n"); return; }
    Args a{};
    for (int i = 0; i < 15; ++i) a.in[i] = (const float*)d_in[i];
    a.out = (float*)d_out; a.ws = (unsigned char*)d_ws;
    hipLaunchKernelGGL(fwd, dim3(grid), dim3(NWAVES * 64), LDS_BYTES, stream, a);
    const hipError_t le = hipPeekAtLastError();
    if (le != hipSuccess) fprintf(stderr, "kernel_launch: launch failed: %s\n", hipGetErrorName(le));
}
```
